# Optimizing an MI355X kernel written in HIP

```python
import math
import jax, jax.numpy as jnp
from jax import lax
import numpy as np

D_MODEL = 1024
BATCH = 8
SEQ = 4096
DEPTH = 1

HEAD_DIM = 64
N_DIFF_HEADS = 4
DIFF_V_DIM = 2 * HEAD_DIM
DIFF_QK_WIDTH = N_DIFF_HEADS * 2 * HEAD_DIM
DIFF_WIDTH = N_DIFF_HEADS * DIFF_V_DIM
N_FOX_HEADS = 8
FOX_WIDTH = N_FOX_HEADS * HEAD_DIM
MIX_WIDTH = DIFF_WIDTH + FOX_WIDTH
IN_PROJ_WIDTH = 2 * DIFF_QK_WIDTH + DIFF_WIDTH + 3 * FOX_WIDTH + N_FOX_HEADS
SPLIT_POINTS = (DIFF_QK_WIDTH, 2 * DIFF_QK_WIDTH, 2 * DIFF_QK_WIDTH + DIFF_WIDTH,
                2 * DIFF_QK_WIDTH + DIFF_WIDTH + FOX_WIDTH,
                2 * DIFF_QK_WIDTH + DIFF_WIDTH + 2 * FOX_WIDTH,
                2 * DIFF_QK_WIDTH + DIFF_WIDTH + 3 * FOX_WIDTH)
Q_BLOCK = 128
N_BUCKETS = 32
MAX_DISTANCE = 128
PEER_HEADS = 8
PEER_QUERY_DIM = 256
PEER_HALF_DIM = PEER_QUERY_DIM // 2
PEER_N_KEYS = 128
PEER_N_EXPERTS = PEER_N_KEYS * PEER_N_KEYS
PEER_TOPK = 16
PEER_CHUNK = 128
EPS = 1e-6
NEG_INF = -1e30

kernel_name = "hymba_diff_fox_peer_block"


def rmsnorm(x, g):
    xf = x.astype(jnp.float32)
    xf = xf * lax.rsqrt(jnp.mean(xf * xf, axis=-1, keepdims=True) + EPS)
    return (xf * g.astype(jnp.float32)).astype(x.dtype)


def t5_bucket(dist):
    max_exact = N_BUCKETS // 2
    nf = jnp.maximum(dist, 1).astype(jnp.float32)
    large = max_exact + (jnp.log(nf / max_exact) / math.log(MAX_DISTANCE / max_exact)
                         * (N_BUCKETS - max_exact)).astype(jnp.int32)
    large = jnp.minimum(large, N_BUCKETS - 1)
    return jnp.where(dist < max_exact, dist, large)


def hybrid_mixer(h, w_in, b_f, lam_q1, lam_k1, lam_q2, lam_k2, g_subln, w_o, rel_bias, lambda_init):
    B, S, _ = h.shape
    proj = h @ w_in
    qd, kd, vd, qf, kf, vf, fl = jnp.split(proj, SPLIT_POINTS, axis=-1)
    qd = qd.reshape(B, S, N_DIFF_HEADS, 2, HEAD_DIM).transpose(0, 2, 3, 1, 4)
    kd = kd.reshape(B, S, N_DIFF_HEADS, 2, HEAD_DIM).transpose(0, 2, 3, 1, 4)
    vd = vd.reshape(B, S, N_DIFF_HEADS, DIFF_V_DIM).transpose(0, 2, 1, 3)
    qf = qf.reshape(B, S, N_FOX_HEADS, HEAD_DIM).transpose(0, 2, 1, 3)
    kf = kf.reshape(B, S, N_FOX_HEADS, HEAD_DIM).transpose(0, 2, 1, 3)
    vf = vf.reshape(B, S, N_FOX_HEADS, HEAD_DIM).transpose(0, 2, 1, 3)
    log_f = jax.nn.log_sigmoid((fl + b_f).astype(jnp.float32))
    cum = jnp.cumsum(log_f, axis=1).transpose(0, 2, 1)
    lam = (jnp.exp(jnp.sum(lam_q1.astype(jnp.float32) * lam_k1.astype(jnp.float32)))
           - jnp.exp(jnp.sum(lam_q2.astype(jnp.float32) * lam_k2.astype(jnp.float32)))
           + lambda_init)
    scale = HEAD_DIM ** -0.5
    k_pos = jnp.arange(S, dtype=jnp.int32)
    n_blocks = S // Q_BLOCK

    def block(i):
        t0 = i * Q_BLOCK
        q_pos = t0 + jnp.arange(Q_BLOCK, dtype=jnp.int32)
        dist = q_pos[:, None] - k_pos[None, :]
        causal = dist >= 0
        bias = jnp.moveaxis(rel_bias[t5_bucket(jnp.maximum(dist, 0))], -1, 0)
        q_blk = lax.dynamic_slice_in_dim(qd, t0, Q_BLOCK, axis=3)
        s_d = (jnp.einsum('bhmqd,bhmkd->bhmqk', q_blk, kd).astype(jnp.float32) * scale
               + bias.astype(jnp.float32)[None, :, None])
        p = jax.nn.softmax(jnp.where(causal, s_d, NEG_INF), axis=-1)
        p_diff = p[:, :, 0] - lam * p[:, :, 1]
        o_d = jnp.einsum('bhqk,bhkd->bhqd', p_diff.astype(vd.dtype), vd)
        o_d = rmsnorm(o_d, g_subln) * (1.0 - lambda_init)
        qf_blk = lax.dynamic_slice_in_dim(qf, t0, Q_BLOCK, axis=2)
        cum_q = lax.dynamic_slice_in_dim(cum, t0, Q_BLOCK, axis=2)
        s_f = (jnp.einsum('bhqd,bhkd->bhqk', qf_blk, kf).astype(jnp.float32) * scale
               + cum_q[..., :, None] - cum[..., None, :])
        p_f = jax.nn.softmax(jnp.where(causal, s_f, NEG_INF), axis=-1)
        o_f = jnp.einsum('bhqk,bhkd->bhqd', p_f.astype(vf.dtype), vf)
        return o_d, o_f

    o_d, o_f = lax.map(block, jnp.arange(n_blocks, dtype=jnp.int32))
    o_d = o_d.transpose(1, 0, 3, 2, 4).reshape(B, S, DIFF_WIDTH)
    o_f = o_f.transpose(1, 0, 3, 2, 4).reshape(B, S, FOX_WIDTH)
    return jnp.concatenate([o_d, o_f], axis=-1) @ w_o


def peer_ffn(h, w_pq, sub_keys, peer_u, peer_v):
    B, S, D = h.shape
    T = B * S
    ht = h.reshape(T, D)
    q = (ht @ w_pq).reshape(T, PEER_HEADS, 2, PEER_HALF_DIM).astype(jnp.float32)
    s = jnp.einsum('thpd,pnd->thpn', q, sub_keys.astype(jnp.float32))
    sv, si = lax.top_k(s, PEER_TOPK)
    cand = sv[..., 0, :, None] + sv[..., 1, None, :]
    cand_id = si[..., 0, :, None] * PEER_N_KEYS + si[..., 1, None, :]
    cand = cand.reshape(T, PEER_HEADS, PEER_TOPK * PEER_TOPK)
    cand_id = cand_id.reshape(T, PEER_HEADS, PEER_TOPK * PEER_TOPK)
    top_s, top_pos = lax.top_k(cand, PEER_TOPK)
    ids = jnp.take_along_axis(cand_id, top_pos, axis=-1)
    g = jax.nn.softmax(top_s, axis=-1)
    nc = T // PEER_CHUNK

    def chunk(args):
        h_c, ids_c, g_c = args
        u = peer_u[ids_c]
        a = jax.nn.gelu(jnp.einsum('chkd,cd->chk', u, h_c).astype(jnp.float32))
        w = (g_c * a).astype(h_c.dtype)
        return jnp.einsum('chk,chkd->cd', w, peer_v[ids_c])

    out = lax.map(chunk, (ht.reshape(nc, PEER_CHUNK, D),
                          ids.reshape(nc, PEER_CHUNK, PEER_HEADS, PEER_TOPK),
                          g.reshape(nc, PEER_CHUNK, PEER_HEADS, PEER_TOPK)))
    return out.reshape(B, S, D)


def setup_inputs(seed: int = 0) -> dict:
    key = jax.random.key(seed)
    ks = jax.random.split(key, 24)
    D = D_MODEL
    nrm = lambda k, shape, s: jax.random.normal(k, shape, jnp.float32) * s
    gain = lambda k, shape: 1.0 + nrm(k, shape, 0.02)
    return {
        "x": nrm(ks[0], (BATCH, SEQ, D), 1.0),
        "c": nrm(ks[1], (BATCH, D), 1.0),
        "rel_bias": nrm(ks[2], (N_BUCKETS, N_DIFF_HEADS), 0.5),
        "w_ada": nrm(ks[3], (DEPTH, D, 6 * D), 0.5 * D ** -0.5),
        "b_ada": nrm(ks[4], (DEPTH, 6 * D), 0.02),
        "g_pre_mix": gain(ks[5], (DEPTH, D)),
        "g_post_mix": gain(ks[6], (DEPTH, D)),
        "w_in": nrm(ks[7], (DEPTH, D, IN_PROJ_WIDTH), D ** -0.5),
        "b_f": 1.0 + nrm(ks[8], (DEPTH, N_FOX_HEADS), 0.5),
        "lam_q1": nrm(ks[9], (DEPTH, HEAD_DIM), 0.1),
        "lam_k1": nrm(ks[10], (DEPTH, HEAD_DIM), 0.1),
        "lam_q2": nrm(ks[11], (DEPTH, HEAD_DIM), 0.1),
        "lam_k2": nrm(ks[12], (DEPTH, HEAD_DIM), 0.1),
        "g_subln": gain(ks[13], (DEPTH, DIFF_V_DIM)),
        "w_o": nrm(ks[14], (DEPTH, MIX_WIDTH, D), MIX_WIDTH ** -0.5),
        "g_pre_ffn": gain(ks[15], (DEPTH, D)),
        "g_post_ffn": gain(ks[16], (DEPTH, D)),
        "w_pq": nrm(ks[17], (DEPTH, D, PEER_HEADS * PEER_QUERY_DIM), D ** -0.5),
        "sub_keys": nrm(ks[18], (DEPTH, 2, PEER_N_KEYS, PEER_HALF_DIM), PEER_HALF_DIM ** -0.5),
        "peer_u": nrm(ks[19], (DEPTH, PEER_N_EXPERTS, D), D ** -0.5),
        "peer_v": nrm(ks[20], (DEPTH, PEER_N_EXPERTS, D), D ** -0.5),
    }


def reference(x, c, rel_bias, w_ada, b_ada, g_pre_mix, g_post_mix, w_in, b_f,
              lam_q1, lam_k1, lam_q2, lam_k2, g_subln, w_o, g_pre_ffn, g_post_ffn,
              w_pq, sub_keys, peer_u, peer_v):
    for l in range(DEPTH):
        lambda_init = 0.8 - 0.6 * math.exp(-0.3 * l)
        mod = jax.nn.silu(c) @ w_ada[l] + b_ada[l]
        sh1, sc1, gt1, sh2, sc2, gt2 = jnp.split(mod[:, None, :], 6, axis=-1)
        h = rmsnorm(x, g_pre_mix[l]) * (1.0 + sc1) + sh1
        y = hybrid_mixer(h, w_in[l], b_f[l], lam_q1[l], lam_k1[l], lam_q2[l], lam_k2[l],
                         g_subln[l], w_o[l], rel_bias, lambda_init)
        x = x + gt1 * rmsnorm(y, g_post_mix[l])
        h = rmsnorm(x, g_pre_ffn[l]) * (1.0 + sc2) + sh2
        y = peer_ffn(h, w_pq[l], sub_keys[l], peer_u[l], peer_v[l])
        x = x + gt2 * rmsnorm(y, g_post_ffn[l])
    return x
```

```cpp
#include <hip/hip_runtime.h>
#include <stdint.h>
#include <math.h>

typedef unsigned short bf16_t;
constexpr int NB = 8, S = 4096, D = 1024, T = NB * S;
constexpr int NPROJ = 3080, NP = 3072;
constexpr float EPS = 1e-6f;
constexpr size_t MiB = 1u << 20;
constexpr size_t WS_CTL = 0;
constexpr size_t WS_SU = 256 * 1024;
constexpr size_t WS_SH = 384 * 1024;
constexpr size_t WS_MOD = 1 * MiB;
constexpr size_t WS_WF = 1 * MiB + 256 * 1024;
constexpr size_t WS_SKB = 1 * MiB + 512 * 1024;
constexpr size_t WS_LOGF = 2 * MiB;
constexpr size_t WS_CS = 3 * MiB;
constexpr size_t WS_S1 = 3 * MiB + 65536;
constexpr size_t WS_WINT = 4 * MiB;
constexpr size_t WS_WOT = 10 * MiB;
constexpr size_t WS_WPQT = 12 * MiB;
constexpr size_t WS_PU = 16 * MiB;
constexpr size_t WS_PV = 48 * MiB;
constexpr size_t WS_H = 80 * MiB;
constexpr size_t WS_PROJ = 144 * MiB;
constexpr size_t WS_X1 = 208 * MiB;
constexpr size_t WS_PQ = 272 * MiB;
constexpr size_t WS_OCAT = 400 * MiB;
constexpr size_t WS_H8 = 400 * MiB;
constexpr size_t WS_IDS = 464 * MiB;
constexpr size_t WS_WB = 472 * MiB;
constexpr size_t WS_G = 480 * MiB;

__device__ __forceinline__ float bf2f(bf16_t v) { return __uint_as_float(((unsigned)v) << 16); }
__device__ __forceinline__ bf16_t f2bf(float f) { unsigned u = __float_as_uint(f); return (bf16_t)((u + 0x7fffu + ((u >> 16) & 1u)) >> 16); }
__device__ __forceinline__ float wave_sum(float v) {
#pragma unroll
    for (int o = 32; o >= 1; o >>= 1) v += __shfl_xor(v, o);
    return v;
}

__device__ __forceinline__ int t5_bucket(int dist) {
    if (dist < 16) return dist;
    float nf = (float)(dist < 1 ? 1 : dist);
    int large = 16 + (int)(logf(nf / 16.f) / logf(128.f / 16.f) * 16.f);
    return large < 31 ? large : 31;
}

namespace pg8 {
#define PG8_LAS __attribute__((address_space(3)))
typedef unsigned short bf16_t;
typedef short bf16x8 __attribute__((ext_vector_type(8)));
typedef float f32x4 __attribute__((ext_vector_type(4)));
typedef unsigned u32x4 __attribute__((ext_vector_type(4)));
typedef int i32x4 __attribute__((ext_vector_type(4)));
template <bool I8> struct AccT { typedef f32x4 type; };
template <> struct AccT<true> { typedef i32x4 type; };
constexpr int BM = 256, BK = 64, HALF = 128, HTB = HALF * BK * 2  , STAGE_BYTES = 8 * HTB, NXCD = 8, WGM = 8;

__host__ __device__ __forceinline__ int lds_byte(int r, int c) { const int st = (r >> 4) * 2 + (c >> 5), rr = r & 15, cc = c & 31, ob = rr * 64 + cc * 2; return st * 1024 + (ob ^ (((ob >> 9) & 1) << 5)); }
__host__ __device__ __forceinline__ void stage_rc(int b, int& R, int& C) { const int st = b / 1024, sb = b % 1024, swz = sb ^ (((sb >> 9) & 1) << 5); R = (st >> 1) * 16 + swz / 64; C = (st & 1) * 32 + (swz % 64) / 2; }
__host__ __device__ __forceinline__ int perm32(int rho) { const int n = rho >> 4, i = rho & 15; return 8 * (i >> 2) + 4 * n + (i & 3); }

struct Unit { int pm, pn; };
struct Gemm { const bf16_t* A; const bf16_t* Bt; int M, N, K; };

struct StaticOrder {
    int nM, nN, nwg, G, c;
    __host__ __device__ void init(int M, int N, int G_, int c_) { nM = M / BM; nN = N / BM; nwg = nM * nN; G = G_; c = c_; }
    __host__ __device__ bool next(int i, Unit& u) const {
        const long L = (long)i * G + c; if (L >= nwg) return false;
        int wgid = (int)L; { const int q = nwg / NXCD, r = nwg % NXCD, xcd = wgid % NXCD, off = wgid / NXCD; wgid = (xcd < r ? xcd * (q + 1) : r * (q + 1) + (xcd - r) * q) + off; }
        const int nig = WGM * nN, gid = wgid / nig, fm = gid * WGM, gsz = (nM - fm) < WGM ? (nM - fm) : WGM;
        u.pm = fm + ((wgid % nig) % gsz); u.pn = (wgid % nig) / gsz; return true;
    }
    __device__ __forceinline__ void a_ready(const Unit&) const {}
    __device__ __forceinline__ void done(const Unit&) const {}
};

__device__ __forceinline__ unsigned cvt_pk_bf16(float lo, float hi) { unsigned r; asm volatile("v_cvt_pk_bf16_f32 %0, %1, %2" : "=v"(r) : "v"(lo), "v"(hi)); return r; }
struct EpiBf16S {
    static constexpr bool PERM = true, AFTER_DRAIN = false;
    bf16_t* O; int ldc; unsigned scale_mask; float scale;
    __device__ __forceinline__ void operator()(const f32x4 (&acc)[2][2][4][2], const Unit& u, int wr, int wc, int fr, int fq) const {
        const int row0 = u.pm * BM + wr * 64 + fr; const int col0 = u.pn * BM + wc * 32 + 8 * fq;
        const float sc = ((scale_mask >> u.pn) & 1u) ? scale : 1.f;
#pragma unroll
        for (int ai = 0; ai < 2; ++ai)
#pragma unroll
            for (int m = 0; m < 4; ++m) { bf16_t* rowp = O + (size_t)(row0 + ai * HALF + m * 16) * ldc + col0;
#pragma unroll
                for (int bj = 0; bj < 2; ++bj) { f32x4 v0 = acc[ai][bj][m][0] * sc, v1 = acc[ai][bj][m][1] * sc;
                    u32x4 w; w.x = cvt_pk_bf16(v0[0], v0[1]); w.y = cvt_pk_bf16(v0[2], v0[3]); w.z = cvt_pk_bf16(v1[0], v1[1]); w.w = cvt_pk_bf16(v1[2], v1[3]);
                    *(u32x4*)(rowp + bj * HALF) = w; } }
    }
};
struct EpiI8S {
    static constexpr bool PERM = true, AFTER_DRAIN = false;
    bf16_t* O; int ldc; const float* rs; const float* cs;
    __device__ __forceinline__ void operator()(const i32x4 (&acc)[2][2][4][2], const Unit& u, int wr, int wc, int fr, int fq) const {
        const int row0 = u.pm * BM + wr * 64 + fr; const int col0 = u.pn * BM + wc * 32 + 8 * fq;
        f32x4 c0[2], c1[2];
#pragma unroll
        for (int bj = 0; bj < 2; ++bj) { c0[bj] = *(const f32x4*)(cs + col0 + bj * HALF); c1[bj] = *(const f32x4*)(cs + col0 + bj * HALF + 4); }
#pragma unroll
        for (int ai = 0; ai < 2; ++ai)
#pragma unroll
            for (int m = 0; m < 4; ++m) { const int r = row0 + ai * HALF + m * 16; bf16_t* rowp = O + (size_t)r * ldc + col0; const float sr = rs[r];
#pragma unroll
                for (int bj = 0; bj < 2; ++bj) { const f32x4 v0 = __builtin_convertvector(acc[ai][bj][m][0], f32x4) * sr * c0[bj], v1 = __builtin_convertvector(acc[ai][bj][m][1], f32x4) * sr * c1[bj];
                    u32x4 w; w.x = cvt_pk_bf16(v0[0], v0[1]); w.y = cvt_pk_bf16(v0[2], v0[3]); w.z = cvt_pk_bf16(v1[0], v1[1]); w.w = cvt_pk_bf16(v1[2], v1[3]);
                    *(u32x4*)(rowp + bj * HALF) = w; } }
    }
};
struct EpiF32 {
    static constexpr bool PERM = false, AFTER_DRAIN = false;
    float* O; int ldc;
    __device__ __forceinline__ void operator()(const f32x4 (&acc)[2][2][4][2], const Unit& u, int wr, int wc, int fr, int fq) const {
        const int col0 = u.pn * BM + wc * 32 + 4 * fq;
#pragma unroll
        for (int ai = 0; ai < 2; ++ai)
#pragma unroll
            for (int m = 0; m < 4; ++m) { float* rowp = O + (size_t)(u.pm * BM + ai * HALF + wr * 64 + m * 16 + fr) * ldc + col0;
#pragma unroll
                for (int bj = 0; bj < 2; ++bj)
#pragma unroll
                    for (int n = 0; n < 2; ++n) *(f32x4*)(rowp + bj * HALF + n * 16) = acc[ai][bj][m][n]; }
    }
};

template <class Epi, class Sched, bool ALIGN_EPI = false, bool SP2 = false, bool I8 = false>
__device__ __forceinline__ void gemm_phase(PG8_LAS unsigned char* lds, const Gemm g, const Sched& S, const Epi& E) {
    int tid_ = threadIdx.x; asm volatile("" : "+v"(tid_));
    const int tid = tid_, wid = __builtin_amdgcn_readfirstlane(tid >> 6), lane = tid & 63, wr = wid >> 2, wc = wid & 3, fr = lane & 15, fq = lane >> 4;
    const int K = g.K, nt = K / BK;
    unsigned voffA[2], voffB[2];
#pragma unroll
    for (int i = 0; i < 2; ++i) { int R, C; stage_rc(tid * 16 + i * 8192, R, C); const int Rb = Epi::PERM ? ((R & ~31) + perm32(R & 31)) : R;
        voffA[i] = (unsigned)(R * K + C) * 2u; voffB[i] = (unsigned)(Rb * K + C) * 2u; }
    const size_t kstep = (size_t)(BK * 2);
    const size_t hstep = (size_t)HALF * K * 2;
    const size_t tstep = 2 * hstep;
    const unsigned ldsw = (unsigned)wid * 1024u;
    const int aoff = lds_byte(wr * 64 + fr, fq * 8), boff = lds_byte(wc * 32 + fr, fq * 8);
#define PG8_SA(b, h) (((b) * 2 + (h)) * HTB)
#define PG8_SB(b, h) ((4 + (b) * 2 + (h)) * HTB)
#define PG8_STAGE(bufoff, gbase, voff) do { _Pragma("unroll") for (int _i = 0; _i < 2; ++_i) \
        __builtin_amdgcn_global_load_lds((const unsigned*)((const char*)(gbase) + (voff)[_i]), (PG8_LAS unsigned*)(lds + (bufoff) + ldsw + _i * 8192), 16, 0, 0); } while (0)
#define PG8_LDA(dst, b, h) do { _Pragma("unroll") for (int m = 0; m < 4; ++m) _Pragma("unroll") for (int k = 0; k < 2; ++k) dst[m][k] = *(const PG8_LAS bf16x8*)(lds + PG8_SA(b, h) + aoff + m * 2048 + k * 1024); } while (0)
#define PG8_LDB(dst, b, h) do { _Pragma("unroll") for (int n = 0; n < 2; ++n) _Pragma("unroll") for (int k = 0; k < 2; ++k) dst[n][k] = *(const PG8_LAS bf16x8*)(lds + PG8_SB(b, h) + boff + n * 2048 + k * 1024); } while (0)
#define PG8_MMA(ai, bj, At, Bt) do { __builtin_amdgcn_s_setprio(1); _Pragma("unroll") for (int m = 0; m < 4; ++m) _Pragma("unroll") for (int n = 0; n < 2; ++n) _Pragma("unroll") for (int k = 0; k < 2; ++k) \
        { if constexpr (I8) acc[ai][bj][m][n] = __builtin_amdgcn_mfma_i32_16x16x64_i8(__builtin_bit_cast(i32x4, Bt[n][k]), __builtin_bit_cast(i32x4, At[m][k]), acc[ai][bj][m][n], 0, 0, 0); \
          else acc[ai][bj][m][n] = __builtin_amdgcn_mfma_f32_16x16x32_bf16(Bt[n][k], At[m][k], acc[ai][bj][m][n], 0, 0, 0); } __builtin_amdgcn_s_setprio(0); } while (0)
#define PG8_WAIT_V(n) asm volatile("s_waitcnt vmcnt(" #n ")" ::: "memory")
#define PG8_WAIT_L(n) asm volatile("s_waitcnt lgkmcnt(" #n ")" ::: "memory")
#define PG8_BAR __builtin_amdgcn_s_barrier()
#define PG8_SCHED __builtin_amdgcn_sched_barrier(0)
    Unit cur, nxt; int ui = 0;
    if (!S.next(0, cur)) return;
    typedef typename AccT<I8>::type acc_t;
    acc_t acc[2][2][4][2];
#pragma unroll
    for (int a = 0; a < 2; ++a)
#pragma unroll
        for (int b = 0; b < 2; ++b)
#pragma unroll
            for (int m = 0; m < 4; ++m)
#pragma unroll
                for (int n = 0; n < 2; ++n) acc[a][b][m][n] = (acc_t){0, 0, 0, 0};
    bf16x8 At[4][2], B0[2][2], B1[2][2];
    const char* cA = (const char*)g.A + (size_t)cur.pm * tstep; const char* cB = (const char*)g.Bt + (size_t)cur.pn * tstep;
    S.a_ready(cur);
    if constexpr (SP2) {
        PG8_STAGE(PG8_SB(0, 0), cB, voffB); PG8_STAGE(PG8_SB(0, 1), cB + hstep, voffB); PG8_STAGE(PG8_SA(0, 0), cA, voffA); PG8_STAGE(PG8_SA(0, 1), cA + hstep, voffA);
        if (wr == 1) PG8_BAR;
        PG8_WAIT_V(2); PG8_BAR;
        PG8_STAGE(PG8_SB(1, 0), cB + kstep, voffB); PG8_STAGE(PG8_SA(1, 0), cA + kstep, voffA); PG8_STAGE(PG8_SB(1, 1), cB + hstep + kstep, voffB);
        PG8_WAIT_V(6); PG8_BAR;
    } else {
        PG8_STAGE(PG8_SB(0, 0), cB, voffB); PG8_STAGE(PG8_SA(0, 0), cA, voffA); PG8_STAGE(PG8_SB(0, 1), cB + hstep, voffB); PG8_STAGE(PG8_SA(0, 1), cA + hstep, voffA);
        if (wr == 1) PG8_BAR;
        PG8_WAIT_V(4); PG8_BAR;
        PG8_STAGE(PG8_SB(1, 0), cB + kstep, voffB); PG8_STAGE(PG8_SA(1, 0), cA + kstep, voffA); PG8_STAGE(PG8_SB(1, 1), cB + hstep + kstep, voffB);
        PG8_WAIT_V(6); PG8_BAR;
    }
    for (;;) {
        const bool has_next = S.next(ui + 1, nxt);
        const char* nA = has_next ? (const char*)g.A + (size_t)nxt.pm * tstep : cA; const char* nB = has_next ? (const char*)g.Bt + (size_t)nxt.pn * tstep : cB;
        for (int t = 0; t < nt; t += 2) {
            const bool last = (t == nt - 2);
            const char* a1 = cA + (size_t)(t + 1) * kstep;
            const char* a2 = last ? nA : cA + (size_t)(t + 2) * kstep; const char* b2 = last ? nB : cB + (size_t)(t + 2) * kstep;
            const char* a3 = a2 + kstep; const char* b3 = b2 + kstep;
            if (last && has_next) S.a_ready(nxt);
            if constexpr (SP2) {
            PG8_LDB(B0, 0, 0); PG8_LDB(B1, 0, 1); PG8_SCHED; PG8_LDA(At, 0, 0); PG8_STAGE(PG8_SA(1, 1), a1 + hstep, voffA);
            PG8_WAIT_V(8); PG8_WAIT_L(0); PG8_BAR; PG8_MMA(0, 0, At, B0); PG8_MMA(0, 1, At, B1); PG8_BAR; PG8_SCHED;
            PG8_LDA(At, 0, 1); PG8_STAGE(PG8_SB(0, 0), b2, voffB); PG8_STAGE(PG8_SB(0, 1), b2 + hstep, voffB); PG8_STAGE(PG8_SA(0, 0), a2, voffA);
            PG8_WAIT_V(8); PG8_WAIT_L(0); PG8_BAR; PG8_MMA(1, 0, At, B0); PG8_MMA(1, 1, At, B1); PG8_BAR; PG8_SCHED;
            PG8_LDB(B0, 1, 0); PG8_LDB(B1, 1, 1); PG8_SCHED; PG8_LDA(At, 1, 0); PG8_STAGE(PG8_SA(0, 1), a2 + hstep, voffA);
            PG8_WAIT_V(8); PG8_WAIT_L(0); PG8_BAR; PG8_MMA(0, 0, At, B0); PG8_MMA(0, 1, At, B1); PG8_BAR; PG8_SCHED;
            PG8_LDA(At, 1, 1); PG8_STAGE(PG8_SB(1, 0), b3, voffB); PG8_STAGE(PG8_SB(1, 1), b3 + hstep, voffB); PG8_STAGE(PG8_SA(1, 0), a3, voffA);
            PG8_WAIT_V(8); PG8_WAIT_L(0); PG8_BAR; PG8_MMA(1, 0, At, B0); PG8_MMA(1, 1, At, B1); PG8_BAR; PG8_SCHED;
            } else {
            PG8_LDB(B0, 0, 0); PG8_SCHED; PG8_LDA(At, 0, 0); PG8_STAGE(PG8_SA(1, 1), a1 + hstep, voffA);
            PG8_WAIT_L(8); PG8_BAR; PG8_WAIT_L(0); PG8_MMA(0, 0, At, B0); PG8_BAR; PG8_SCHED;
            PG8_LDB(B1, 0, 1); PG8_STAGE(PG8_SB(0, 0), b2, voffB);
            PG8_BAR; PG8_WAIT_L(0); PG8_MMA(0, 1, At, B1); PG8_BAR;
            PG8_LDA(At, 0, 1); PG8_STAGE(PG8_SA(0, 0), a2, voffA);
            PG8_BAR; PG8_WAIT_L(0); PG8_MMA(1, 0, At, B0); PG8_BAR; PG8_SCHED;
            PG8_STAGE(PG8_SB(0, 1), b2 + hstep, voffB);
            PG8_WAIT_V(6); PG8_BAR; PG8_MMA(1, 1, At, B1); PG8_BAR;
            PG8_LDB(B0, 1, 0); PG8_SCHED; PG8_LDA(At, 1, 0); PG8_STAGE(PG8_SA(0, 1), a2 + hstep, voffA);
            PG8_WAIT_L(8); PG8_BAR; PG8_WAIT_L(0); PG8_MMA(0, 0, At, B0); PG8_BAR; PG8_SCHED;
            PG8_LDB(B1, 1, 1); PG8_STAGE(PG8_SB(1, 0), b3, voffB);
            PG8_BAR; PG8_WAIT_L(0); PG8_MMA(0, 1, At, B1); PG8_BAR;
            PG8_LDA(At, 1, 1); PG8_STAGE(PG8_SA(1, 0), a3, voffA);
            PG8_BAR; PG8_WAIT_L(0); PG8_MMA(1, 0, At, B0); PG8_BAR; PG8_SCHED;
            PG8_STAGE(PG8_SB(1, 1), b3 + hstep, voffB);
            PG8_WAIT_V(6); PG8_BAR; PG8_MMA(1, 1, At, B1); PG8_BAR;
            }
        }
        if constexpr (ALIGN_EPI) { if (wr == 0) PG8_BAR; }
        if constexpr (!Epi::AFTER_DRAIN) { E(acc, cur, wr, wc, fr, fq); S.done(cur); }
        if (!has_next) break;
#pragma unroll
        for (int a = 0; a < 2; ++a)
#pragma unroll
            for (int b = 0; b < 2; ++b)
#pragma unroll
                for (int m = 0; m < 4; ++m)
#pragma unroll
                    for (int n = 0; n < 2; ++n) acc[a][b][m][n] = (acc_t){0, 0, 0, 0};
        cur = nxt; cA = nA; cB = nB; ++ui;
        if constexpr (ALIGN_EPI) { if (wr == 1) PG8_BAR; }
    }
    PG8_WAIT_V(0);
    if constexpr (!ALIGN_EPI) { if (wr == 0) PG8_BAR; }
    PG8_BAR;
    if constexpr (Epi::AFTER_DRAIN) { E.fused(acc, cur, wr, wc, fr, fq, lds, wid, lane); S.done(cur); }
#undef PG8_SA
#undef PG8_SB
#undef PG8_STAGE
#undef PG8_LDA
#undef PG8_LDB
#undef PG8_MMA
#undef PG8_WAIT_V
#undef PG8_WAIT_L
#undef PG8_BAR
#undef PG8_SCHED
}
}

#define LAS __attribute__((address_space(3)))
typedef float f32x4 __attribute__((ext_vector_type(4)));
typedef unsigned v4u __attribute__((ext_vector_type(4)));
constexpr int NTHR = 512, NWAVE = 8;
constexpr int LDS_BYTES = 147456;
constexpr float C2 = 0.125f * 1.4426950408889634f;

struct Params {
    const float *x, *c, *rel_bias, *w_ada, *b_ada, *g_pre_mix, *g_post_mix, *w_in, *b_f, *lq1, *lk1, *lq2, *lk2, *g_subln, *w_o, *g_pre_ffn, *g_post_ffn, *w_pq, *sub_keys, *peer_u, *peer_v;
    float* out; unsigned char* ws;
};
__device__ __forceinline__ int otid() { int t = threadIdx.x; asm volatile("" : "+v"(t)); return t; }
__device__ __forceinline__ unsigned pk2(float lo, float hi) { return (unsigned)f2bf(lo) | ((unsigned)f2bf(hi) << 16); }

__device__ __forceinline__ void p0_transpose_item(const float* W, int K, int N, int ldw, bf16_t* WT, LAS float* scr, int item, int lane) {
    const int nblk = N / 32, kb = item / nblk, nb = item % nblk, k0 = 64 * kb, n0 = 32 * nb;
#pragma unroll 8
    for (int i = 0; i < 32; ++i) { const int kk = 2 * i + (lane >> 5); scr[kk * 33 + (lane & 31)] = W[(size_t)(k0 + kk) * ldw + n0 + (lane & 31)]; }
    asm volatile("s_waitcnt lgkmcnt(0)" ::: "memory");
    const int c = lane & 7;
#pragma unroll
    for (int j = 0; j < 4; ++j) { const int n = (lane >> 3) + 8 * j; const LAS float* s = scr + (8 * c) * 33 + n;
        v4u o; o.x = pk2(s[0 * 33], s[1 * 33]); o.y = pk2(s[2 * 33], s[3 * 33]); o.z = pk2(s[4 * 33], s[5 * 33]); o.w = pk2(s[6 * 33], s[7 * 33]);
        *(v4u*)(WT + (size_t)(n0 + n) * K + k0 + 8 * c) = o; }
    asm volatile("s_waitcnt lgkmcnt(0)" ::: "memory");
}

__device__ __forceinline__ void p0_quant_panel(const float* W, int ldw, int n0, unsigned char* WT8, float* csout, float csmul, LAS unsigned char* lds, int tid) {
    const int lane = tid & 63, wave = tid >> 6;
    LAS float* scr = (LAS float*)(lds + wave * 17408);
    LAS float* red = (LAS float*)(lds + 8 * 17408);
#pragma unroll 8
    for (int i = 0; i < 64; ++i) { const int kk = 2 * i + (lane >> 5); scr[kk * 33 + (lane & 31)] = W[(size_t)(128 * wave + kk) * ldw + n0 + (lane & 31)]; }
    asm volatile("s_waitcnt lgkmcnt(0)" ::: "memory");
    { const int n = lane & 31, half = lane >> 5; float m = 0.f;
#pragma unroll 8
      for (int i = 0; i < 64; ++i) m = fmaxf(m, fabsf(scr[(64 * half + i) * 33 + n]));
      red[(2 * wave + half) * 32 + n] = m; }
    __syncthreads();
    const int c = lane & 7;
#pragma unroll
    for (int j = 0; j < 4; ++j) { const int n = (lane >> 3) + 8 * j; float mx = 0.f;
#pragma unroll
        for (int q = 0; q < 16; ++q) mx = fmaxf(mx, red[q * 32 + n]);
        const float sc = mx > 0.f ? mx * (1.f / 127.f) : 1.f, inv = 1.f / sc;
        if (wave == 0 && c == 0) csout[n0 + n] = sc * csmul;
        const LAS float* s_ = scr + (16 * c) * 33 + n; v4u o;
#pragma unroll
        for (int k = 0; k < 4; ++k) { const int q0 = __float2int_rn(s_[(4 * k) * 33] * inv), q1 = __float2int_rn(s_[(4 * k + 1) * 33] * inv), q2 = __float2int_rn(s_[(4 * k + 2) * 33] * inv), q3 = __float2int_rn(s_[(4 * k + 3) * 33] * inv);
            o[k] = (unsigned)(q0 & 255) | ((unsigned)(q1 & 255) << 8) | ((unsigned)(q2 & 255) << 16) | ((unsigned)(q3 & 255) << 24); }
        *(v4u*)(WT8 + (size_t)(n0 + n) * 1024 + 128 * wave + 16 * c) = o; }
    __syncthreads();
}

__device__ __forceinline__ void phase0(const Params& p, LAS unsigned char* lds) {
    const int tid = otid(), lane = tid & 63, wave = tid >> 6, G = gridDim.x, bid = blockIdx.x;
    unsigned char* ws = p.ws;
    if (bid < 192) {
        LAS float* sl = (LAS float*)lds;
        LAS float* red = (LAS float*)(lds + 32768);
        for (int i = tid; i < 8192; i += NTHR) { float v = p.c[i]; sl[i] = v / (1.f + expf(-v)); }
        __syncthreads();
      for (int ch = bid; ch < 192; ch += G) {
        const int col = tid & 31, isl = tid >> 5, c0 = ch * 32;
        float acc[8];
#pragma unroll
        for (int b = 0; b < 8; ++b) acc[b] = 0.f;
        for (int ii = 0; ii < 64; ++ii) { const int i = isl * 64 + ii; const float w = p.w_ada[(size_t)i * 6144 + c0 + col];
#pragma unroll
            for (int b = 0; b < 8; ++b) acc[b] += sl[b * 1024 + i] * w; }
#pragma unroll
        for (int b = 0; b < 8; ++b) red[(isl * 8 + b) * 32 + col] = acc[b];
        __syncthreads();
        if (tid < 256) { const int b = tid >> 5; float s = 0.f;
#pragma unroll
            for (int k = 0; k < 16; ++k) s += red[(k * 8 + b) * 32 + col];
            ((float*)(ws + WS_MOD))[b * 6144 + c0 + col] = s + p.b_ada[c0 + col]; }
        __syncthreads();
      }
    }
    for (int pn = G - 1 - bid; pn < 160; pn += G) {
        if (pn < 64) p0_quant_panel(p.w_pq, 2048, 32 * pn, ws + WS_WPQT, (float*)(ws + WS_CS) + 3072, 1.f, lds, tid);
        else { const int n0 = 32 * (pn - 64);
            p0_quant_panel(p.w_in, NPROJ, n0, ws + WS_WINT, (float*)(ws + WS_CS), (n0 < 512 || (n0 >= 1536 && n0 < 2048)) ? C2 : 1.f, lds, tid); } }
    {
        LAS float* scr = (LAS float*)(lds + wave * 16384);
        const int gw = bid * NWAVE + wave, NGW = G * NWAVE;
        constexpr int I_O = 16 * 32;
        for (int it = gw; it < I_O; it += NGW) p0_transpose_item(p.w_o, 1024, 1024, 1024, (bf16_t*)(ws + WS_WOT), scr, it, lane);
    }
    const int gt = bid * NTHR + tid, NGT = G * NTHR;
    for (int i = gt; i < 8192; i += NGT) { const int hh = i >> 10, k = i & 1023; ((float*)(ws + WS_WF))[i] = p.w_in[(size_t)k * NPROJ + NP + hh]; }
    for (int i = gt; i < 32768 / 2; i += NGT) { ((unsigned*)(ws + WS_SKB))[i] = pk2(p.sub_keys[2 * i], p.sub_keys[2 * i + 1]); }
    {
        const int gw = bid * NWAVE + wave, NGW = G * NWAVE;
        float* su = (float*)(ws + WS_SU);
        for (int e0 = gw; e0 < 16384; e0 += 2 * NGW) {
            f32x4 a[2][4];
#pragma unroll
            for (int u = 0; u < 2; ++u) { const int e = (e0 + u * NGW < 16384) ? e0 + u * NGW : e0;
#pragma unroll
                for (int k = 0; k < 4; ++k) a[u][k] = *(const f32x4*)(p.peer_u + (size_t)e * 1024 + lane * 16 + 4 * k); }
#pragma unroll
            for (int u = 0; u < 2; ++u) { const int e = e0 + u * NGW; if (e < 16384) {
                float am = 0.f;
#pragma unroll
                for (int k = 0; k < 4; ++k) am = fmaxf(am, fmaxf(fmaxf(fabsf(a[u][k][0]), fabsf(a[u][k][1])), fmaxf(fabsf(a[u][k][2]), fabsf(a[u][k][3]))));
#pragma unroll
                for (int o_ = 1; o_ < 64; o_ <<= 1) am = fmaxf(am, __shfl_xor(am, o_));
                const float sc = am > 0.f ? am * (1.f / 127.f) : 1.f, inv = 1.f / sc;
                v4u o;
#pragma unroll
                for (int k = 0; k < 4; ++k) { const int q0 = __float2int_rn(a[u][k][0] * inv), q1 = __float2int_rn(a[u][k][1] * inv), q2 = __float2int_rn(a[u][k][2] * inv), q3 = __float2int_rn(a[u][k][3] * inv);
                    o[k] = (unsigned)(q0 & 255) | ((unsigned)(q1 & 255) << 8) | ((unsigned)(q2 & 255) << 16) | ((unsigned)(q3 & 255) << 24); }
                *(v4u*)(ws + WS_PU + (size_t)(lane >> 3) * ((size_t)16384 * 128) + (size_t)e * 128 + (lane & 7) * 16) = o;
                if (lane == 0) su[e] = sc; } }
        }
    }
    constexpr int NIT = 16384 * 64;
    for (int i0 = gt; i0 < NIT; i0 += 4 * NGT) {
        f32x4 a[4][4];
#pragma unroll
        for (int u = 0; u < 4; ++u) { const int i = (i0 + u * NGT < NIT) ? i0 + u * NGT : i0; const int e = i >> 6, cc = i & 63;
            const float* src = p.peer_v + (size_t)e * 1024 + cc * 16;
#pragma unroll
            for (int k = 0; k < 4; ++k) a[u][k] = *(const f32x4*)(src + 4 * k); }
#pragma unroll
        for (int u = 0; u < 4; ++u) { const int i = i0 + u * NGT; if (i < NIT) { const int e = i >> 6, cc = i & 63;
            unsigned char* dst = ws + WS_PV + (size_t)(cc >> 3) * ((size_t)16384 * 128) + (size_t)e * 128 + (cc & 7) * 16;
            v4u o;
#pragma unroll
            for (int k = 0; k < 4; ++k) { int w = __builtin_amdgcn_cvt_pk_fp8_f32(a[u][k][0] * 64.f, a[u][k][1] * 64.f, 0, false); w = __builtin_amdgcn_cvt_pk_fp8_f32(a[u][k][2] * 64.f, a[u][k][3] * 64.f, w, true); o[k] = (unsigned)w; }
            *(v4u*)dst = o; } }
    }
}


namespace att {
typedef short bf16x8 __attribute__((ext_vector_type(8)));
typedef float f32x16 __attribute__((ext_vector_type(16)));
typedef short s16x4 __attribute__((ext_vector_type(4)));
typedef short v4i16_t __attribute__((ext_vector_type(4)));
constexpr int L_K = 0;
constexpr int L_V = 16384;
constexpr int L_WSF = 49152;
constexpr int L_NB = 51200;
constexpr int L_TBL = 67584;
constexpr int L_SCAN = 68096;
constexpr int L_STG = 70144;
constexpr int L_END = 135680;
static_assert(L_END <= LDS_BYTES, "attention LDS map");
__device__ __forceinline__ int crow(int r, int hi) { return (r & 3) + 8 * (r >> 2) + 4 * hi; }
__device__ __forceinline__ s16x4 vtr(const LAS unsigned char* p) { return __builtin_bit_cast(s16x4, __builtin_amdgcn_ds_read_tr16_b64_v4i16((LAS v4i16_t*)p)); }
__device__ __forceinline__ float xhalf_max(float m) { auto rr = __builtin_amdgcn_permlane32_swap(__float_as_uint(m), __float_as_uint(m), false, false); return fmaxf(__uint_as_float(rr[0]), __uint_as_float(rr[1])); }
__device__ __forceinline__ float xhalf_sum(float m) { auto rr = __builtin_amdgcn_permlane32_swap(__float_as_uint(m), __float_as_uint(m), false, false); return __uint_as_float(rr[0]) + __uint_as_float(rr[1]); }

__device__ __forceinline__ float max3f(float a, float b, float c) { float r; asm("v_max3_f32 %0, %1, %2, %3" : "=v"(r) : "v"(a), "v"(b), "v"(c)); return r; }
__device__ __forceinline__ float wave_min32(float v) {
#pragma unroll
    for (int o = 1; o < 32; o <<= 1) v = fminf(v, __shfl_xor(v, o));
    return v;
}
constexpr float RESC_THR = 8.f;
constexpr float PRUNE_THR = 24.f;

template <int DV, int MODE>
__device__ __forceinline__ void attn_pass(f32x16 (&o)[DV / 32], const bf16_t* __restrict__ proj, int b, int q0, int qcol, int kcol, int vcol, float kmax, LAS unsigned char* lds, int tid) {
    asm volatile("" : "+v"(tid));
    const int lane = tid & 63, wid = __builtin_amdgcn_readfirstlane(tid >> 6), r32 = lane & 31, hi = lane >> 5;
    const size_t rowbase = (size_t)b * S;
    bf16x8 qr[4];
    { const bf16_t* qp = proj + (rowbase + q0 + wid * 32 + r32) * NP + qcol + hi * 8;
#pragma unroll
      for (int d0 = 0; d0 < 4; ++d0) qr[d0] = *(const bf16x8*)(qp + d0 * 16); }
    asm volatile("" : "+v"(qr[0]), "+v"(qr[1]), "+v"(qr[2]), "+v"(qr[3]));
    float qkb = 0.f;
    if (MODE == 1) { float ssq = 0.f;
#pragma unroll
        for (int d0 = 0; d0 < 4; ++d0)
#pragma unroll
            for (int j = 0; j < 8; ++j) { const float f = bf2f((bf16_t)qr[d0][j]); ssq += f * f; }
        ssq = xhalf_sum(ssq);
        float mx = ssq;
#pragma unroll
        for (int o_ = 1; o_ < 32; o_ <<= 1) mx = fmaxf(mx, __shfl_xor(mx, o_));
        qkb = sqrtf(mx) * kmax * 1.0001f; }
    const int srow = tid >> 3, sch = tid & 7;
    const unsigned kgo = (unsigned)(srow * NP + kcol + sch * 8) * 2u;
    const int kw = sch * 1024 + ((srow + sch) & 63) * 16;
    constexpr int NVP = DV / 64;
    unsigned vgo[NVP]; int vw[NVP];
#pragma unroll
    for (int j = 0; j < NVP; ++j) { const int i = tid + 512 * j; const int row = (DV == 64) ? (i >> 3) : (i >> 4), ch = (DV == 64) ? (i & 7) : (i & 15);
        vgo[j] = (unsigned)(row * NP + vcol + ch * 8) * 2u; vw[j] = (ch >> 2) * 4096 + (row >> 4) * 1024 + (row & 15) * 64 + (ch & 3) * 16; }
    const unsigned char* slab0 = (const unsigned char*)(proj + rowbase * NP);
    v4u kreg, vreg[NVP];
    LAS float* wsf = (LAS float*)(lds + L_WSF) + wid * 64;
    const LAS float* nb = (const LAS float*)(lds + L_NB);
    const LAS float* tbl = (const LAS float*)(lds + L_TBL);
    volatile LAS unsigned* flags = (volatile LAS unsigned*)(lds + L_SCAN + 64);
    float m = 0.f, l = 0.f; bool first = true, wdone = false;
#pragma unroll
    for (int d0 = 0; d0 < DV / 32; ++d0)
#pragma unroll
        for (int r = 0; r < 16; ++r) o[d0][r] = 0.f;
    const int NT = (q0 + 256) / 64;
    const int qw0 = q0 + wid * 32, qabs = qw0 + r32;
    { const unsigned char* sl = slab0 + (size_t)(NT - 1) * 64 * NP * 2;
      kreg = *(const v4u*)(sl + kgo);
#pragma unroll
      for (int j = 0; j < NVP; ++j) vreg[j] = *(const v4u*)(sl + vgo[j]); }
    *(LAS v4u*)(lds + L_K + kw) = kreg;
#pragma unroll
    for (int j = 0; j < NVP; ++j) *(LAS v4u*)(lds + L_V + vw[j]) = vreg[j];
    if (MODE == 1 && tid < 8) flags[tid] = 0u;
    __syncthreads();
    const int vlane = ((lane >> 4) & 1) * 32 + (lane & 3) * 8 + (4 * hi + ((lane & 15) >> 2)) * 64;
    int cur = 0;
    for (int t = NT - 1; t >= 0; --t) {
        const int s0 = t * 64;
        if (t > 0) { const unsigned char* sl = slab0 + (size_t)(s0 - 64) * NP * 2;
            kreg = *(const v4u*)(sl + kgo);
#pragma unroll
            for (int j = 0; j < NVP; ++j) vreg[j] = *(const v4u*)(sl + vgo[j]); }
        if (s0 <= qw0 + 31 && !wdone) {
            f32x16 p0, p1;
            if (MODE == 1) {
#pragma unroll
                for (int g4 = 0; g4 < 4; ++g4) { const f32x4 a = *(const LAS f32x4*)(nb + s0 + 8 * g4 + 4 * hi), c = *(const LAS f32x4*)(nb + s0 + 32 + 8 * g4 + 4 * hi);
#pragma unroll
                    for (int e = 0; e < 4; ++e) { p0[4 * g4 + e] = a[e] - m; p1[4 * g4 + e] = c[e] - m; } }
            } else {
#pragma unroll
                for (int r = 0; r < 16; ++r) { p0[r] = -m; p1[r] = -m; } }
            const LAS unsigned char* kb = lds + L_K + cur * 8192;
            { bf16x8 ka[8];
#pragma unroll
              for (int d0 = 0; d0 < 4; ++d0) { const int c = 2 * d0 + hi;
                  ka[2 * d0] = *(const LAS bf16x8*)(kb + c * 1024 + ((r32 + c) & 63) * 16);
                  ka[2 * d0 + 1] = *(const LAS bf16x8*)(kb + c * 1024 + ((r32 + 32 + c) & 63) * 16); }
#pragma unroll
              for (int d0 = 0; d0 < 4; ++d0) { p0 = __builtin_amdgcn_mfma_f32_32x32x16_bf16(ka[2 * d0], qr[d0], p0, 0, 0, 0); p1 = __builtin_amdgcn_mfma_f32_32x32x16_bf16(ka[2 * d0 + 1], qr[d0], p1, 0, 0, 0); } }
            const LAS unsigned char* vb = lds + L_V + cur * 16384 + vlane;
            constexpr int ND = DV / 32;
            s16x4 fa[ND][2][2];
#pragma unroll
            for (int d0 = 0; d0 < (ND < 2 ? ND : 2); ++d0)
#pragma unroll
                for (int i = 0; i < 2; ++i) { fa[d0][i][0] = vtr(vb + d0 * 4096 + i * 1024); fa[d0][i][1] = vtr(vb + d0 * 4096 + i * 1024 + 512); }
            const bool band = (MODE == 0) ? (s0 + 63 + 112 >= qw0) : (s0 + 63 > qw0);
            if (band) {
                int qh = qabs - 4 * hi - s0; asm volatile("" : "+v"(qh));
#pragma unroll
                for (int r = 0; r < 16; ++r) { const int d0_ = qh - ((r & 3) + 8 * (r >> 2)), d1_ = d0_ - 32;
                    if (MODE == 0) { const float b0 = tbl[d0_ < 0 ? 0 : (d0_ > 127 ? 127 : d0_)], b1 = tbl[d1_ < 0 ? 0 : (d1_ > 127 ? 127 : d1_)];
                        p0[r] = d0_ < 0 ? -INFINITY : p0[r] + b0; p1[r] = d1_ < 0 ? -INFINITY : p1[r] + b1; }
                    else { p0[r] = d0_ < 0 ? -INFINITY : p0[r]; p1[r] = d1_ < 0 ? -INFINITY : p1[r]; } }
            }
            asm volatile("s_nop 15\n\ts_nop 7" : "+v"(p0), "+v"(p1));
            float ra = max3f(p0[0], p0[1], p1[0]), rb = max3f(p0[2], p0[3], p1[1]); ra = max3f(ra, p1[2], p1[3]);
#pragma unroll
            for (int r = 4; r < 16; r += 4) { ra = max3f(ra, p0[r], p0[r + 1]); rb = max3f(rb, p0[r + 2], p0[r + 3]); ra = max3f(ra, p1[r], p1[r + 1]); rb = max3f(rb, p1[r + 2], p1[r + 3]); }
            float rm = xhalf_max(fmaxf(ra, rb));
            if (first || __any(rm > RESC_THR)) {
                const float dl = first ? rm : fmaxf(rm, 0.f), alpha = first ? 1.f : __builtin_amdgcn_exp2f(-dl);
                m += dl; l *= alpha;
#pragma unroll
                for (int r = 0; r < 16; ++r) { p0[r] -= dl; p1[r] -= dl; }
                if (!first) {
                    if (hi == 0) wsf[r32] = alpha;
                    asm volatile("s_waitcnt lgkmcnt(0)" ::: "memory");
#pragma unroll
                    for (int r = 0; r < 16; ++r) { const float f = wsf[crow(r, hi)];
#pragma unroll
                        for (int d0 = 0; d0 < DV / 32; ++d0) o[d0][r] *= f; }
                }
                first = false;
            }
            float rs = 0.f;
#pragma unroll
            for (int r = 0; r < 16; ++r) { p0[r] = __builtin_amdgcn_exp2f(p0[r]); rs += p0[r]; }
            v4u pw[4];
#pragma unroll
            for (int i = 0; i < 4; ++i) { pw[0][i] = pg8::cvt_pk_bf16(p0[2 * i], p0[2 * i + 1]); pw[1][i] = pg8::cvt_pk_bf16(p0[8 + 2 * i], p0[8 + 2 * i + 1]); }
#pragma unroll
            for (int d0 = 2; d0 < ND; ++d0)
#pragma unroll
                for (int i = 0; i < 2; ++i) { fa[d0][i][0] = vtr(vb + d0 * 4096 + i * 1024); fa[d0][i][1] = vtr(vb + d0 * 4096 + i * 1024 + 512); }
            __builtin_amdgcn_sched_barrier(0);
#pragma unroll
            for (int d0 = 0; d0 < ND; ++d0) {
#pragma unroll
                for (int i = 0; i < 2; ++i) { const s16x4 a_ = fa[d0][i][0], b_ = fa[d0][i][1]; const bf16x8 vf = (bf16x8){a_[0], a_[1], a_[2], a_[3], b_[0], b_[1], b_[2], b_[3]};
                    o[d0] = __builtin_amdgcn_mfma_f32_32x32x16_bf16(__builtin_bit_cast(bf16x8, pw[i]), vf, o[d0], 0, 0, 0); }
                __builtin_amdgcn_sched_barrier(0);
#pragma unroll
                for (int i = 0; i < 2; ++i) { fa[d0][i][0] = vtr(vb + d0 * 4096 + (2 + i) * 1024); fa[d0][i][1] = vtr(vb + d0 * 4096 + (2 + i) * 1024 + 512); }
#pragma unroll
                for (int r = d0 * (16 / ND); r < (d0 + 1) * (16 / ND); ++r) { p1[r] = __builtin_amdgcn_exp2f(p1[r]); rs += p1[r]; }
                __builtin_amdgcn_sched_barrier(0);
            }
            l += rs;
#pragma unroll
            for (int i = 0; i < 4; ++i) { pw[2][i] = pg8::cvt_pk_bf16(p1[2 * i], p1[2 * i + 1]); pw[3][i] = pg8::cvt_pk_bf16(p1[8 + 2 * i], p1[8 + 2 * i + 1]); }
#pragma unroll
            for (int d0 = 0; d0 < ND; ++d0)
#pragma unroll
                for (int i = 0; i < 2; ++i) { const s16x4 a_ = fa[d0][i][0], b_ = fa[d0][i][1]; const bf16x8 vf = (bf16x8){a_[0], a_[1], a_[2], a_[3], b_[0], b_[1], b_[2], b_[3]};
                    o[d0] = __builtin_amdgcn_mfma_f32_32x32x16_bf16(__builtin_bit_cast(bf16x8, pw[2 + i]), vf, o[d0], 0, 0, 0); }
        }
        if (t > 0) { *(LAS v4u*)(lds + L_K + (cur ^ 1) * 8192 + kw) = kreg;
#pragma unroll
            for (int j = 0; j < NVP; ++j) *(LAS v4u*)(lds + L_V + (cur ^ 1) * 16384 + vw[j]) = vreg[j]; }
        if (MODE == 1 && t > 0 && !wdone && !first && (s0 - 1 < qw0)) {
            const float ub = qkb + nb[s0 - 1];
            if (ub < wave_min32(m) - PRUNE_THR) { wdone = true; if (lane == 0) flags[wid] = 1u; }
        }
        __syncthreads();
        if (MODE == 1) { const unsigned all = flags[0] & flags[1] & flags[2] & flags[3] & flags[4] & flags[5] & flags[6] & flags[7]; if (all) break; }
        cur ^= 1;
    }
    if (MODE == 1) __syncthreads();
    l = xhalf_sum(l);
    if (hi == 0) wsf[r32] = 1.f / l;
    asm volatile("s_waitcnt lgkmcnt(0)" ::: "memory");
#pragma unroll
    for (int r = 0; r < 16; ++r) { const float f = wsf[crow(r, hi)];
#pragma unroll
        for (int d0 = 0; d0 < DV / 32; ++d0) o[d0][r] *= f; }
}

__device__ __forceinline__ void fox_kmax(const Params& p, int b, int h, LAS unsigned char* lds, int tid) {
    const bf16_t* kb = (const bf16_t*)(p.ws + WS_PROJ) + (size_t)b * S * NP + 2048 + h * 64;
    float mx = 0.f;
    for (int s = tid; s < S; s += NTHR) { float ss = 0.f;
#pragma unroll
        for (int c = 0; c < 8; ++c) { const v4u w = *(const v4u*)(kb + (size_t)s * NP + c * 8);
#pragma unroll
            for (int k = 0; k < 4; ++k) { const float f0 = __uint_as_float(w[k] << 16), f1 = __uint_as_float(w[k] & 0xffff0000u); ss += f0 * f0 + f1 * f1; } }
        mx = fmaxf(mx, ss); }
#pragma unroll
    for (int o_ = 1; o_ < 64; o_ <<= 1) mx = fmaxf(mx, __shfl_xor(mx, o_));
    LAS float* sc = (LAS float*)(lds + L_SCAN);
    if ((tid & 63) == 0) sc[48 + (tid >> 6)] = mx;
    __syncthreads();
    if (tid == 0) { float v = sc[48];
        for (int w = 1; w < 8; ++w) v = fmaxf(v, sc[48 + w]);
        sc[32] = sqrtf(v); }
    __syncthreads();
}

template <int NC>
__device__ __forceinline__ void stage_store(LAS unsigned char* stg, bf16_t* gbase  , int lane) {
    asm volatile("" : "+v"(lane));
    asm volatile("s_waitcnt lgkmcnt(0)" ::: "memory");
    constexpr int CPR = NC / 8;
#pragma unroll
    for (int i = 0; i < 32 * CPR / 64; ++i) { const int idx = i * 64 + lane, row = idx / CPR, ch = idx % CPR;
        const v4u v = *(const LAS v4u*)(stg + row * (NC * 2) + ch * 16); *(v4u*)(gbase + (size_t)row * D + ch * 8) = v; }
    asm volatile("s_waitcnt lgkmcnt(0)" ::: "memory");
}

__device__ __forceinline__ void fox_unit(const Params& p, int b, int h, int qb, LAS unsigned char* lds, int tid) {
    const int lane = tid & 63, wid = __builtin_amdgcn_readfirstlane(tid >> 6), r32 = lane & 31, hi = lane >> 5;
    const int q0 = qb * 256, n = q0 + 256;
    const bf16_t* proj = (const bf16_t*)(p.ws + WS_PROJ);
    { LAS float* nbw = (LAS float*)(lds + L_NB); LAS float* sc = (LAS float*)(lds + L_SCAN);
      const float* lf = (const float*)(p.ws + WS_LOGF) + (size_t)b * S * 8 + h;
      float v[8]; float run = 0.f;
#pragma unroll
      for (int e = 0; e < 8; ++e) { const int s = tid * 8 + e; const float x = (s < n) ? lf[(size_t)s * 8] : 0.f; run += x; v[e] = run; }
      float inc = run;
#pragma unroll
      for (int o_ = 1; o_ < 64; o_ <<= 1) { const float y = __shfl_up(inc, o_); if (lane >= o_) inc += y; }
      if (lane == 63) sc[wid] = inc;
      __syncthreads();
      float base = inc - run;
      for (int w = 0; w < wid; ++w) base += sc[w];
#pragma unroll
      for (int e = 0; e < 8; ++e) nbw[tid * 8 + e] = base + v[e];
      __syncthreads();
      const float ref = (q0 > 0) ? nbw[q0 - 1] : 0.f;
      __syncthreads();
#pragma unroll
      for (int e = 0; e < 8; ++e) nbw[tid * 8 + e] = -(base + v[e] - ref) * 1.4426950408889634f;
      __syncthreads(); }
    f32x16 o[2];
    attn_pass<64, 1>(o, proj, b, q0, 1536 + h * 64, 2048 + h * 64, 2560 + h * 64, *(const LAS float*)(lds + L_SCAN + 128), lds, tid);
    LAS unsigned char* stg = lds + L_STG + wid * 8192;
    { int sb = hi * 512 + r32 * 2; asm volatile("" : "+v"(sb));
#pragma unroll
    for (int r = 0; r < 16; ++r)
#pragma unroll
        for (int d0 = 0; d0 < 2; ++d0) *(LAS bf16_t*)(stg + sb + ((r & 3) + 8 * (r >> 2)) * 128 + d0 * 64) = f2bf(o[d0][r]); }
    stage_store<64>(stg, (bf16_t*)(p.ws + WS_OCAT) + ((size_t)b * S + q0 + wid * 32) * D + 512 + h * 64, lane);
}

__device__ __forceinline__ void diff_unit(const Params& p, int b, int h, int qb, float lam, LAS unsigned char* lds, int tid) {
    const int lane = tid & 63, wid = __builtin_amdgcn_readfirstlane(tid >> 6), r32 = lane & 31, hi = lane >> 5;
    const int q0 = qb * 256;
    const bf16_t* proj = (const bf16_t*)(p.ws + WS_PROJ);
    if (tid < 128) { LAS float* tb = (LAS float*)(lds + L_TBL); tb[tid] = (p.rel_bias[t5_bucket(tid) * 4 + h] - p.rel_bias[31 * 4 + h]) * 1.4426950408889634f; }
    __syncthreads();
    LAS unsigned char* stg = lds + L_STG + wid * 8192;
    f32x16 o[4];
    attn_pass<128, 0>(o, proj, b, q0, h * 128, 512 + h * 128, 1024 + h * 128, 0.f, lds, tid);
    { int sb = hi * 1024 + r32 * 2; asm volatile("" : "+v"(sb));
#pragma unroll
    for (int d0 = 0; d0 < 4; ++d0)
#pragma unroll
        for (int r = 0; r < 16; ++r) *(LAS bf16_t*)(stg + sb + ((r & 3) + 8 * (r >> 2)) * 256 + d0 * 64) = f2bf(o[d0][r]); }
    attn_pass<128, 0>(o, proj, b, q0, h * 128 + 64, 512 + h * 128 + 64, 1024 + h * 128, 0.f, lds, tid);
    float ss[16];
#pragma unroll
    for (int r = 0; r < 16; ++r) ss[r] = 0.f;
    int sb2 = hi * 1024 + r32 * 2; asm volatile("" : "+v"(sb2));
#pragma unroll
    for (int d0 = 0; d0 < 4; ++d0)
#pragma unroll
        for (int r = 0; r < 16; ++r) { const float a0 = bf2f(*(const LAS bf16_t*)(stg + sb2 + ((r & 3) + 8 * (r >> 2)) * 256 + d0 * 64));
            const float e0 = a0 - lam * o[d0][r]; o[d0][r] = e0; ss[r] += e0 * e0; }
#pragma unroll
    for (int r = 0; r < 16; ++r) {
#pragma unroll
        for (int x_ = 1; x_ < 32; x_ <<= 1) ss[r] += __shfl_xor(ss[r], x_);
        ss[r] = rsqrtf(ss[r] * (1.f / 128.f) + EPS) * 0.8f; }
#pragma unroll
    for (int d0 = 0; d0 < 4; ++d0) { const float gg = p.g_subln[d0 * 32 + r32];
#pragma unroll
        for (int r = 0; r < 16; ++r) *(LAS bf16_t*)(stg + sb2 + ((r & 3) + 8 * (r >> 2)) * 256 + d0 * 64) = f2bf(o[d0][r] * ss[r] * gg); }
    stage_store<128>(stg, (bf16_t*)(p.ws + WS_OCAT) + ((size_t)b * S + q0 + wid * 32) * D + h * 128, lane);
}

__device__ __forceinline__ void attn_phase(const Params& p, LAS unsigned char* lds) {
    const int tid = otid(), lane = tid & 63, G = gridDim.x, bx = blockIdx.x;
    const int vcu = (G % 8 == 0) ? (bx % 8) * (G / 8) + bx / 8 : bx;
    const float lam = expf(wave_sum(p.lq1[lane] * p.lk1[lane])) - expf(wave_sum(p.lq2[lane] * p.lk2[lane])) + 0.2f;
    for (int slot = vcu; slot < 256; slot += G) {
        { const int bh = slot >> 3, s = slot & 7;
          for (int i = 0; i < 2; ++i) diff_unit(p, bh >> 2, bh & 3, i == 0 ? 15 - s : s, lam, lds, tid); }
        { const int bh = slot >> 2, s = slot & 3; const int b = bh >> 3, h = bh & 7;
          fox_kmax(p, b, h, lds, tid);
          for (int i = 0; i < 4; ++i) { const int qb = (i == 0) ? 15 - s : (i == 1) ? 8 + s : (i == 2) ? 7 - s : s; fox_unit(p, b, h, qb, lds, tid); } }
    }
}
}


namespace tk {
typedef short bf16x8 __attribute__((ext_vector_type(8)));
typedef float f32x16 __attribute__((ext_vector_type(16)));
constexpr int L_SK = 0;
constexpr int L_TAB = 65536;
#define TK_CE(a, b) do { const float t_ = __builtin_fmaxf(a, b); b = __builtin_fminf(a, b); a = t_; } while (0)
__device__ __forceinline__ void sort16(float (&v)[16]) {
    TK_CE(v[0], v[1]); TK_CE(v[2], v[3]); TK_CE(v[0], v[2]); TK_CE(v[1], v[3]); TK_CE(v[1], v[2]); TK_CE(v[4], v[5]); TK_CE(v[6], v[7]); TK_CE(v[4], v[6]); TK_CE(v[5], v[7]); TK_CE(v[5], v[6]); TK_CE(v[0], v[4]); TK_CE(v[2], v[6]); TK_CE(v[2], v[4]); TK_CE(v[1], v[5]); TK_CE(v[3], v[7]); TK_CE(v[3], v[5]); TK_CE(v[1], v[2]); TK_CE(v[3], v[4]); TK_CE(v[5], v[6]); TK_CE(v[8], v[9]); TK_CE(v[10], v[11]); TK_CE(v[8], v[10]); TK_CE(v[9], v[11]); TK_CE(v[9], v[10]); TK_CE(v[12], v[13]); TK_CE(v[14], v[15]); TK_CE(v[12], v[14]); TK_CE(v[13], v[15]); TK_CE(v[13], v[14]); TK_CE(v[8], v[12]); TK_CE(v[10], v[14]); TK_CE(v[10], v[12]); TK_CE(v[9], v[13]); TK_CE(v[11], v[15]); TK_CE(v[11], v[13]); TK_CE(v[9], v[10]); TK_CE(v[11], v[12]); TK_CE(v[13], v[14]); TK_CE(v[0], v[8]); TK_CE(v[4], v[12]); TK_CE(v[4], v[8]); TK_CE(v[2], v[10]); TK_CE(v[6], v[14]); TK_CE(v[6], v[10]); TK_CE(v[2], v[4]); TK_CE(v[6], v[8]); TK_CE(v[10], v[12]); TK_CE(v[1], v[9]); TK_CE(v[5], v[13]); TK_CE(v[5], v[9]); TK_CE(v[3], v[11]); TK_CE(v[7], v[15]); TK_CE(v[7], v[11]); TK_CE(v[3], v[5]); TK_CE(v[7], v[9]); TK_CE(v[11], v[13]); TK_CE(v[1], v[2]); TK_CE(v[3], v[4]); TK_CE(v[5], v[6]); TK_CE(v[7], v[8]); TK_CE(v[9], v[10]); TK_CE(v[11], v[12]); TK_CE(v[13], v[14]);
}
__device__ __forceinline__ void merge8x8(float (&v)[16]) {
    TK_CE(v[0], v[8]); TK_CE(v[4], v[12]); TK_CE(v[4], v[8]); TK_CE(v[2], v[10]); TK_CE(v[6], v[14]); TK_CE(v[6], v[10]); TK_CE(v[2], v[4]); TK_CE(v[6], v[8]); TK_CE(v[10], v[12]); TK_CE(v[1], v[9]); TK_CE(v[5], v[13]); TK_CE(v[5], v[9]); TK_CE(v[3], v[11]); TK_CE(v[7], v[15]); TK_CE(v[7], v[11]); TK_CE(v[3], v[5]); TK_CE(v[7], v[9]); TK_CE(v[11], v[13]); TK_CE(v[1], v[2]); TK_CE(v[3], v[4]); TK_CE(v[5], v[6]); TK_CE(v[7], v[8]); TK_CE(v[9], v[10]); TK_CE(v[11], v[12]); TK_CE(v[13], v[14]);
}
__device__ __forceinline__ void merge16(float (&a)[16], const float (&b)[16]) {
#pragma unroll
    for (int i = 0; i < 16; ++i) a[i] = __builtin_fmaxf(a[i], b[15 - i]);
#pragma unroll
    for (int j = 8; j > 0; j >>= 1)
#pragma unroll
        for (int i = 0; i < 16; ++i) { const int l = i ^ j; if (l > i) TK_CE(a[i], a[l]); }
}
__device__ __forceinline__ void load_q(bf16x8 (&qb)[8], const bf16_t* __restrict__ qrow) {
#pragma unroll
    for (int ks = 0; ks < 8; ++ks) qb[ks] = *(const bf16x8*)(qrow + ks * 16);
}
__device__ __forceinline__ void side_scores(f32x16 (&acc)[4], const bf16x8 (&qb)[8], const LAS unsigned char* skp, int r32, int hi) {
#pragma unroll
    for (int mt = 0; mt < 4; ++mt) {
#pragma unroll
        for (int r = 0; r < 16; ++r) acc[mt][r] = 0.f;
#pragma unroll
        for (int ks = 0; ks < 8; ++ks) { const bf16x8 a = *(const LAS bf16x8*)(skp + (2 * ks + hi) * 2048 + (32 * mt + r32) * 16);
            acc[mt] = __builtin_amdgcn_mfma_f32_32x32x16_bf16(a, qb[ks], acc[mt], 0, 0, 0); } }
}
__device__ __forceinline__ void side_top16(float (&top)[16], const f32x16 (&acc)[4], int hi) {
    float w[16];
#pragma unroll
    for (int mt = 0; mt < 4; ++mt) {
        float* dst = (mt == 0) ? top : w;
#pragma unroll
        for (int r = 0; r < 16; ++r) { const unsigned n = 32 * mt + (r & 3) + 8 * (r >> 2) + 4 * hi; dst[r] = __uint_as_float((__float_as_uint(acc[mt][r]) & ~127u) | n); }
        if (mt == 0) sort16(top); else { sort16(w); merge16(top, w); }
    }
    float a0[16], a1[16];
#pragma unroll
    for (int i = 0; i < 16; ++i) { auto rr = __builtin_amdgcn_permlane32_swap(__float_as_uint(top[i]), __float_as_uint(top[i]), false, false); a0[i] = __uint_as_float(rr[0]); a1[i] = __uint_as_float(rr[1]); }
    merge16(a0, a1);
#pragma unroll
    for (int i = 0; i < 16; ++i) top[i] = a0[i];
}

__device__ __forceinline__ void topk_phase(const Params& p, LAS unsigned char* lds) {
    const int tid = otid(), lane = tid & 63, wave = __builtin_amdgcn_readfirstlane(tid >> 6), r32 = lane & 31, hi = lane >> 5, G = gridDim.x;
    { const v4u* src = (const v4u*)(p.ws + WS_SKB);
      for (int i = tid; i < 4096; i += NTHR) { const int pp = i >> 11, n = (i >> 4) & 127, c = i & 15; *(LAS v4u*)(lds + L_SK + pp * 32768 + c * 2048 + n * 16) = src[i]; }
      __syncthreads(); }
    const bf16_t* pq = (const bf16_t*)(p.ws + WS_PQ);
    bf16_t* ids = (bf16_t*)(p.ws + WS_IDS); float* gout = (float*)(p.ws + WS_G);
    LAS unsigned char* tab = lds + L_TAB + wave * 2048 + lane * 32;
    bf16x8 q0[8], q1[8];
    { const int item0 = blockIdx.x * NWAVE + wave; if (item0 < T * 8 / 32) { const bf16_t* qrow = pq + ((size_t)item0 * 32 + r32) * 256 + hi * 8; load_q(q0, qrow); load_q(q1, qrow + 128); } }
    for (int item = blockIdx.x * NWAVE + wave; item < T * 8 / 32; item += G * NWAVE) {
        const size_t row = (size_t)item * 32 + r32;
        float s0[16], s1[16];
        { f32x16 acc[4]; side_scores(acc, q0, lds + L_SK, r32, hi); side_top16(s0, acc, hi); }
        { f32x16 acc[4]; side_scores(acc, q1, lds + L_SK + 32768, r32, hi);
          { const int nxt = item + G * NWAVE; const int ic = nxt < T * 8 / 32 ? nxt : item;
            const bf16_t* qrow = pq + ((size_t)ic * 32 + r32) * 256 + hi * 8; load_q(q0, qrow); load_q(q1, qrow + 128); }
          side_top16(s1, acc, hi); }
#pragma unroll
        for (int i = 0; i < 16; i += 4) {
            *(LAS unsigned*)(tab + i) = (__float_as_uint(s0[i]) & 127u) | ((__float_as_uint(s0[i + 1]) & 127u) << 8) | ((__float_as_uint(s0[i + 2]) & 127u) << 16) | ((__float_as_uint(s0[i + 3]) & 127u) << 24);
            *(LAS unsigned*)(tab + 16 + i) = (__float_as_uint(s1[i]) & 127u) | ((__float_as_uint(s1[i + 1]) & 127u) << 8) | ((__float_as_uint(s1[i + 2]) & 127u) << 16) | ((__float_as_uint(s1[i + 3]) & 127u) << 24); }
        float c0[16], c1[16], c2[16], c3[16];
#define TK_C(i, j) __uint_as_float((__float_as_uint(s0[i] + s1[j]) & ~255u) | (unsigned)((i) * 16 + (j)))
        c0[0] = TK_C(0, 0); c0[1] = TK_C(0, 1); c0[2] = TK_C(0, 2); c0[3] = TK_C(0, 3); c0[4] = TK_C(0, 4); c0[5] = TK_C(0, 5); c0[6] = TK_C(0, 6); c0[7] = TK_C(0, 7);
        c0[8] = TK_C(0, 8); c0[9] = TK_C(0, 9); c0[10] = TK_C(0, 10); c0[11] = TK_C(0, 11); c0[12] = TK_C(0, 12); c0[13] = TK_C(0, 13); c0[14] = TK_C(0, 14); c0[15] = TK_C(0, 15);
        c1[0] = TK_C(1, 0); c1[1] = TK_C(1, 1); c1[2] = TK_C(1, 2); c1[3] = TK_C(1, 3); c1[4] = TK_C(1, 4); c1[5] = TK_C(1, 5); c1[6] = TK_C(1, 6); c1[7] = TK_C(1, 7);
        c1[8] = TK_C(8, 0); c1[9] = TK_C(9, 0); c1[10] = TK_C(10, 0); c1[11] = TK_C(11, 0); c1[12] = TK_C(12, 0); c1[13] = TK_C(13, 0); c1[14] = TK_C(14, 0); c1[15] = TK_C(15, 0);
        c2[0] = TK_C(2, 0); c2[1] = TK_C(2, 1); c2[2] = TK_C(2, 2); c2[3] = TK_C(2, 3); c2[4] = TK_C(2, 4); c2[5] = TK_C(3, 0); c2[6] = TK_C(3, 1); c2[7] = TK_C(3, 2);
        c2[8] = TK_C(3, 3); c2[9] = TK_C(4, 0); c2[10] = TK_C(4, 1); c2[11] = TK_C(4, 2); c2[12] = TK_C(5, 0); c2[13] = TK_C(5, 1); c2[14] = TK_C(6, 0); c2[15] = TK_C(6, 1);
        c3[0] = TK_C(7, 0); c3[1] = TK_C(7, 1);
#pragma unroll
        for (int i = 2; i < 16; ++i) c3[i] = -INFINITY;
#undef TK_C
        merge8x8(c1); merge16(c0, c1); sort16(c2); merge16(c2, c3); merge16(c0, c2);
        float e[16], sum = 0.f;
#pragma unroll
        for (int k = 0; k < 16; ++k) { e[k] = __expf(c0[k] - c0[0]); sum += e[k]; }
        const float inv = 1.f / sum;
        unsigned idv[16];
#pragma unroll
        for (int k = 0; k < 16; ++k) { const unsigned ij = __float_as_uint(c0[k]) & 255u; const unsigned n0 = *(const LAS unsigned char*)(tab + (ij >> 4)), n1 = *(const LAS unsigned char*)(tab + 16 + (ij & 15u)); idv[k] = n0 * 128u + n1; }
        if (hi == 0) {
#pragma unroll
            for (int k = 0; k < 16; k += 8) *(v4u*)(ids + row * 16 + k) = (v4u){idv[k] | (idv[k + 1] << 16), idv[k + 2] | (idv[k + 3] << 16), idv[k + 4] | (idv[k + 5] << 16), idv[k + 6] | (idv[k + 7] << 16)};
#pragma unroll
            for (int k = 0; k < 16; k += 4) *(f32x4*)(gout + row * 16 + k) = (f32x4){e[k] * inv, e[k + 1] * inv, e[k + 2] * inv, e[k + 3] * inv};
        }
    }
}
}


namespace rw {
typedef __bf16 bf16x2 __attribute__((ext_vector_type(2)));
__device__ __forceinline__ float dot2(unsigned a, unsigned b, float c) { return __builtin_amdgcn_fdot2_f32_bf16(__builtin_bit_cast(bf16x2, a), __builtin_bit_cast(bf16x2, b), c, false); }

constexpr int RW = 4;
__device__ __forceinline__ f32x4 bf4(uint2 w) { return (f32x4){__uint_as_float(w.x << 16), __uint_as_float(w.x & 0xffff0000u), __uint_as_float(w.y << 16), __uint_as_float(w.y & 0xffff0000u)}; }
__device__ __forceinline__ void norm1_phase(const Params& p, LAS unsigned char* lds) {
    const int tid = otid(), lane = tid & 63, wave = tid >> 6;
    const float* mod = (const float*)(p.ws + WS_MOD);
    unsigned char* hout = p.ws + WS_H; float* logf_ = (float*)(p.ws + WS_LOGF);
    { const f32x4* src = (const f32x4*)(p.ws + WS_WF); LAS f32x4* dst = (LAS f32x4*)lds; for (int i = tid; i < 2048; i += NTHR) dst[i] = src[i]; }
    __syncthreads();
    const LAS float* wf = (const LAS float*)lds;
    const int rpb = (T + gridDim.x - 1) / gridDim.x, r0 = blockIdx.x * rpb, r1 = (r0 + rpb < T) ? r0 + rpb : T;
    int cb = -1; f32x4 ga[4], sh[4];
    for (int t0 = r0 + wave; t0 < r1; t0 += NWAVE * RW) {
        f32x4 xv[RW][4];
#pragma unroll
        for (int i = 0; i < RW; ++i) { const int t = t0 + i * NWAVE < r1 ? t0 + i * NWAVE : t0;
#pragma unroll
            for (int j = 0; j < 4; ++j) xv[i][j] = *(const f32x4*)(p.x + (size_t)t * D + lane * 4 + 256 * j); }
#pragma unroll
        for (int i = 0; i < RW; ++i) { const int t = t0 + i * NWAVE; if (t < r1) {
            const int bb = __builtin_amdgcn_readfirstlane(t / S);
            if (bb != cb) { cb = bb; const float* mb = mod + bb * 6144;
#pragma unroll
                for (int j = 0; j < 4; ++j) { const int col = lane * 4 + 256 * j; ga[j] = *(const f32x4*)(p.g_pre_mix + col) * (*(const f32x4*)(mb + 1024 + col) + 1.f); sh[j] = *(const f32x4*)(mb + col); } }
            f32x4 (&v)[4] = xv[i]; float ss = 0.f;
#pragma unroll
            for (int j = 0; j < 4; ++j) ss += v[j][0] * v[j][0] + v[j][1] * v[j][1] + v[j][2] * v[j][2] + v[j][3] * v[j][3];
            ss = wave_sum(ss); const float r = rsqrtf(ss * (1.f / D) + EPS);
            float am = 0.f;
#pragma unroll
            for (int j = 0; j < 4; ++j) { v[j] = v[j] * r * ga[j] + sh[j]; am = fmaxf(am, fmaxf(fmaxf(fabsf(v[j][0]), fabsf(v[j][1])), fmaxf(fabsf(v[j][2]), fabsf(v[j][3])))); }
#pragma unroll
            for (int o_ = 1; o_ < 64; o_ <<= 1) am = fmaxf(am, __shfl_xor(am, o_));
            { const float qs = am > 0.f ? am * (1.f / 127.f) : 1.f, qi = 1.f / qs;
#pragma unroll
              for (int j = 0; j < 4; ++j) { const int col = lane * 4 + 256 * j; const int q0 = __float2int_rn(v[j][0] * qi), q1 = __float2int_rn(v[j][1] * qi), q2 = __float2int_rn(v[j][2] * qi), q3 = __float2int_rn(v[j][3] * qi);
                  *(unsigned*)(hout + (size_t)t * D + col) = (unsigned)(q0 & 255) | ((unsigned)(q1 & 255) << 8) | ((unsigned)(q2 & 255) << 16) | ((unsigned)(q3 & 255) << 24); }
              if (lane == 0) ((float*)(p.ws + WS_S1))[t] = qs; }
            float d8[8];
#pragma unroll
            for (int hq = 0; hq < 4; ++hq) {
#pragma unroll
                for (int h2_ = 0; h2_ < 2; ++h2_) { const int hh = 2 * hq + h2_; float s_ = 0.f;
#pragma unroll
                    for (int j = 0; j < 4; ++j) { const f32x4 w = *(const LAS f32x4*)(wf + hh * 1024 + lane * 4 + 256 * j); s_ += v[j][0] * w[0] + v[j][1] * w[1] + v[j][2] * w[2] + v[j][3] * w[3]; }
                    d8[hh] = s_; }
                __builtin_amdgcn_sched_barrier(0); }
            float q4[4], q2[2], z;
#pragma unroll
            for (int k = 0; k < 4; ++k) { const float snd = (lane & 32) ? d8[k] : d8[k + 4]; q4[k] = ((lane & 32) ? d8[k + 4] : d8[k]) + __shfl_xor(snd, 32); }
#pragma unroll
            for (int k = 0; k < 2; ++k) { const float snd = (lane & 16) ? q4[k] : q4[k + 2]; q2[k] = ((lane & 16) ? q4[k + 2] : q4[k]) + __shfl_xor(snd, 16); }
            { const float snd = (lane & 8) ? q2[0] : q2[1]; z = ((lane & 8) ? q2[1] : q2[0]) + __shfl_xor(snd, 8); }
            z += __shfl_xor(z, 4); z += __shfl_xor(z, 2); z += __shfl_xor(z, 1);
            if ((lane & 7) == 0) { const int hh = ((lane >> 5) & 1) * 4 + ((lane >> 4) & 1) * 2 + ((lane >> 3) & 1); z += p.b_f[hh]; logf_[(size_t)t * 8 + hh] = -(fmaxf(-z, 0.f) + log1pf(expf(-fabsf(z)))); }
        } }
    }
    __syncthreads();
}
__device__ __forceinline__ void post1_phase(const Params& p) {
    const int tid = otid(), lane = tid & 63, wave = tid >> 6;
    const float* mod = (const float*)(p.ws + WS_MOD); const bf16_t* y = (const bf16_t*)(p.ws + WS_PROJ);
    const int rpb = (T + gridDim.x - 1) / gridDim.x, r0 = blockIdx.x * rpb, r1 = (r0 + rpb < T) ? r0 + rpb : T;
    int cb = -1; f32x4 ga[4], gb[4], sh[4];
    for (int t0 = r0 + wave; t0 < r1; t0 += NWAVE * RW) {
        f32x4 xa[RW][4]; uint2 ya[RW][4];
#pragma unroll
        for (int i = 0; i < RW; ++i) { const int t = t0 + i * NWAVE < r1 ? t0 + i * NWAVE : t0;
#pragma unroll
            for (int j = 0; j < 4; ++j) { ya[i][j] = *(const uint2*)(y + (size_t)t * D + lane * 4 + 256 * j); xa[i][j] = *(const f32x4*)(p.x + (size_t)t * D + lane * 4 + 256 * j); } }
#pragma unroll
        for (int i = 0; i < RW; ++i) { const int t = t0 + i * NWAVE; if (t < r1) {
            const int bb = __builtin_amdgcn_readfirstlane(t / S);
            if (bb != cb) { cb = bb; const float* mb = mod + bb * 6144;
#pragma unroll
                for (int j = 0; j < 4; ++j) { const int col = lane * 4 + 256 * j; ga[j] = *(const f32x4*)(p.g_post_mix + col) * *(const f32x4*)(mb + 2048 + col);
                    gb[j] = *(const f32x4*)(p.g_pre_ffn + col) * (*(const f32x4*)(mb + 4096 + col) + 1.f); sh[j] = *(const f32x4*)(mb + 3072 + col); } }
            f32x4 (&xv)[4] = xa[i]; f32x4 yv[4]; float ss = 0.f;
#pragma unroll
            for (int j = 0; j < 4; ++j) { yv[j] = bf4(ya[i][j]); ss += yv[j][0] * yv[j][0] + yv[j][1] * yv[j][1] + yv[j][2] * yv[j][2] + yv[j][3] * yv[j][3]; }
            ss = wave_sum(ss); const float r = rsqrtf(ss * (1.f / D) + EPS); float s2 = 0.f;
#pragma unroll
            for (int j = 0; j < 4; ++j) { const int col = lane * 4 + 256 * j; xv[j] = xv[j] + yv[j] * r * ga[j]; s2 += xv[j][0] * xv[j][0] + xv[j][1] * xv[j][1] + xv[j][2] * xv[j][2] + xv[j][3] * xv[j][3];
                *(uint2*)((bf16_t*)(p.ws + WS_X1) + (size_t)t * D + col) = make_uint2(pk2(xv[j][0], xv[j][1]), pk2(xv[j][2], xv[j][3])); }
            s2 = wave_sum(s2); const float r2 = rsqrtf(s2 * (1.f / D) + EPS);
            float am = 0.f;
#pragma unroll
            for (int j = 0; j < 4; ++j) { const int col = lane * 4 + 256 * j; const f32x4 o = xv[j] * r2 * gb[j] + sh[j]; xv[j] = o;
                am = fmaxf(am, fmaxf(fmaxf(fabsf(o[0]), fabsf(o[1])), fmaxf(fabsf(o[2]), fabsf(o[3])))); }
#pragma unroll
            for (int o_ = 1; o_ < 64; o_ <<= 1) am = fmaxf(am, __shfl_xor(am, o_));
            const float qs = am > 0.f ? am * (1.f / 127.f) : 1.f, qi = 1.f / qs;
#pragma unroll
            for (int j = 0; j < 4; ++j) { const int col = lane * 4 + 256 * j; const int q0 = __float2int_rn(xv[j][0] * qi), q1 = __float2int_rn(xv[j][1] * qi), q2 = __float2int_rn(xv[j][2] * qi), q3 = __float2int_rn(xv[j][3] * qi);
                *(unsigned*)(p.ws + WS_H8 + (size_t)t * D + col) = (unsigned)(q0 & 255) | ((unsigned)(q1 & 255) << 8) | ((unsigned)(q2 & 255) << 16) | ((unsigned)(q3 & 255) << 24); }
            if (lane == 0) ((float*)(p.ws + WS_SH))[t] = qs;
        } }
    }
}

}


namespace sh {
typedef __bf16 bf16x2 __attribute__((ext_vector_type(2)));
typedef float f32x2 __attribute__((ext_vector_type(2)));
constexpr float USCALE = 64.f;
constexpr size_t SHARD_BYTES = (size_t)16384 * 128;
struct Split { int xs0, xs1, nq, q; };
__device__ __forceinline__ Split split(int tid) { Split s; const int G = gridDim.x, b = blockIdx.x; if (G % 8 == 0) { s.xs0 = b & 7; s.xs1 = s.xs0 + 1; s.nq = (G >> 3) * NWAVE; s.q = (b >> 3) * NWAVE + __builtin_amdgcn_readfirstlane(tid >> 6); } else { s.xs0 = 0; s.xs1 = 8; s.nq = G * NWAVE; s.q = b * NWAVE + __builtin_amdgcn_readfirstlane(tid >> 6); } return s; }

__device__ __forceinline__ void u_phase(const Params& p) {
    const int tid = otid(), lane = tid & 63, g = lane >> 3, c = lane & 7;
    const unsigned char* h8 = p.ws + WS_H8; const bf16_t* ids = (const bf16_t*)(p.ws + WS_IDS); bf16_t* apart = (bf16_t*)(p.ws + WS_PQ);
    const Split sp = split(tid);
    const int j0 = ((lane >> 2) & 1) * 8 + ((lane >> 1) & 1) * 4 + (lane & 1) * 2;
    for (int xs = sp.xs0; xs < sp.xs1; ++xs) {
        const unsigned char* U8 = p.ws + WS_PU + (size_t)xs * SHARD_BYTES + c * 16;
        const unsigned char* hb = h8 + xs * 128 + c * 16;
        v4u uA[16], uB[16], hA[1], hB[1], iA[2], iB[2];
#define U_IDS(I, tk) do { const int tc_ = (tk) < T ? (tk) : T - 1; const v4u* ip_ = (const v4u*)(ids + (size_t)tc_ * 128 + g * 16); I[0] = ip_[0]; I[1] = ip_[1]; } while (0)
#define U_GATHER(U, H, I, tk) do { const int tc_ = (tk) < T ? (tk) : T - 1; H[0] = *(const v4u*)(hb + (size_t)tc_ * D); \
        _Pragma("unroll") for (int j = 0; j < 16; ++j) U[j] = *(const v4u*)(U8 + (size_t)((I[j >> 3][(j >> 1) & 3] >> (16 * (j & 1))) & 0xffffu) * 128); } while (0)
#define U_COMPUTE(U, H, tk) do { { float d[16]; \
        _Pragma("unroll") for (int j = 0; j < 16; ++j) { int s_ = 0; \
            _Pragma("unroll") for (int k = 0; k < 4; ++k) s_ = __builtin_amdgcn_sdot4((int)U[j][k], (int)H[0][k], s_, false); \
            d[j] = (float)s_; } \
        float q8[8], q4[4], q2[2]; \
        _Pragma("unroll") for (int i = 0; i < 8; ++i) { const float snd = (lane & 4) ? d[i] : d[i + 8]; q8[i] = ((lane & 4) ? d[i + 8] : d[i]) + __shfl_xor(snd, 4); } \
        _Pragma("unroll") for (int i = 0; i < 4; ++i) { const float snd = (lane & 2) ? q8[i] : q8[i + 4]; q4[i] = ((lane & 2) ? q8[i + 4] : q8[i]) + __shfl_xor(snd, 2); } \
        _Pragma("unroll") for (int i = 0; i < 2; ++i) { const float snd = (lane & 1) ? q4[i] : q4[i + 2]; q2[i] = ((lane & 1) ? q4[i + 2] : q4[i]) + __shfl_xor(snd, 1); } \
        if ((tk) < T) *(unsigned*)(apart + ((size_t)(tk) * 8 + xs) * 128 + g * 16 + j0) = pk2(q2[0], q2[1]); } } while (0)
        const int nq = sp.nq;
        U_IDS(iA, sp.q); U_IDS(iB, sp.q + nq);
        U_GATHER(uA, hA, iA, sp.q);
        for (int t = sp.q; t < T; t += 2 * nq) {
            U_IDS(iA, t + 2 * nq); U_GATHER(uB, hB, iB, t + nq); U_COMPUTE(uA, hA, t);
            U_IDS(iB, t + 3 * nq); U_GATHER(uA, hA, iA, t + 2 * nq); U_COMPUTE(uB, hB, t + nq);
        }
#undef U_IDS
#undef U_GATHER
#undef U_COMPUTE
    }
}
__device__ __forceinline__ void combine_phase(const Params& p) {
    const bf16_t* apart = (const bf16_t*)(p.ws + WS_PQ); const float* gw = (const float*)(p.ws + WS_G);
    for (int i = blockIdx.x * NTHR + otid(); i < T * 16; i += gridDim.x * NTHR) {
        const int t = i >> 4, e0 = (i & 15) * 8; float a[8];
#pragma unroll
        for (int k = 0; k < 8; ++k) a[k] = 0.f;
        v4u pv[8];
#pragma unroll
        for (int x = 0; x < 8; ++x) pv[x] = *(const v4u*)(apart + ((size_t)t * 8 + x) * 128 + e0);
        const f32x4 g0 = *(const f32x4*)(gw + (size_t)t * 128 + e0), g1 = *(const f32x4*)(gw + (size_t)t * 128 + e0 + 4);
#pragma unroll
        for (int x = 0; x < 8; ++x)
#pragma unroll
            for (int k = 0; k < 4; ++k) { a[2 * k] += __uint_as_float(pv[x][k] << 16); a[2 * k + 1] += __uint_as_float(pv[x][k] & 0xffff0000u); }
        { const v4u idw = *(const v4u*)((const bf16_t*)(p.ws + WS_IDS) + (size_t)t * 128 + e0); const float sht = ((const float*)(p.ws + WS_SH))[t]; const float* su = (const float*)(p.ws + WS_SU);
#pragma unroll
          for (int k = 0; k < 8; ++k) a[k] *= su[(idw[k >> 1] >> (16 * (k & 1))) & 0xffffu] * sht; }
        float w[8];
#pragma unroll
        for (int k = 0; k < 8; ++k) { const float u3 = 0.7978845608028654f * (a[k] + 0.044715f * a[k] * a[k] * a[k]); w[k] = (k < 4 ? g0[k] : g1[k - 4]) * 0.5f * a[k] * (1.f + tanhf(u3)) * (1.f / USCALE); }
        { int h0 = __builtin_amdgcn_cvt_pk_fp8_f32(w[0] * 4096.f, w[1] * 4096.f, 0, false); h0 = __builtin_amdgcn_cvt_pk_fp8_f32(w[2] * 4096.f, w[3] * 4096.f, h0, true);
          int h1 = __builtin_amdgcn_cvt_pk_fp8_f32(w[4] * 4096.f, w[5] * 4096.f, 0, false); h1 = __builtin_amdgcn_cvt_pk_fp8_f32(w[6] * 4096.f, w[7] * 4096.f, h1, true);
          const f32x2 a0 = __builtin_amdgcn_cvt_pk_f32_fp8(h0, false), a1 = __builtin_amdgcn_cvt_pk_f32_fp8(h0, true), a2 = __builtin_amdgcn_cvt_pk_f32_fp8(h1, false), a3 = __builtin_amdgcn_cvt_pk_f32_fp8(h1, true);
          int l0 = __builtin_amdgcn_cvt_pk_fp8_f32(w[0] * 4096.f - a0.x, w[1] * 4096.f - a0.y, 0, false); l0 = __builtin_amdgcn_cvt_pk_fp8_f32(w[2] * 4096.f - a1.x, w[3] * 4096.f - a1.y, l0, true);
          int l1 = __builtin_amdgcn_cvt_pk_fp8_f32(w[4] * 4096.f - a2.x, w[5] * 4096.f - a2.y, 0, false); l1 = __builtin_amdgcn_cvt_pk_fp8_f32(w[6] * 4096.f - a3.x, w[7] * 4096.f - a3.y, l1, true);
          unsigned char* wr_ = p.ws + WS_WB + (size_t)t * 256 + 8 * (e0 & 15) + (e0 >> 4);
#pragma unroll
          for (int k = 0; k < 8; ++k) { wr_[8 * k] = (unsigned char)(((k < 4 ? h0 : h1) >> (8 * (k & 3))) & 255); wr_[128 + 8 * k] = (unsigned char)(((k < 4 ? l0 : l1) >> (8 * (k & 3))) & 255); } }
    }
}
__device__ __forceinline__ void v_phase(const Params& p, LAS unsigned char* lds) {
    typedef int v2i_t __attribute__((ext_vector_type(2)));
    typedef unsigned v2u_t __attribute__((ext_vector_type(2)));
    const int tid = otid(), lane = tid & 63, r = lane >> 3, pc = lane & 7, li = lane & 15, kg = lane >> 4;
    const int wv = __builtin_amdgcn_readfirstlane(tid >> 6);
    const unsigned char* ids8 = p.ws + WS_IDS; const unsigned char* w8 = p.ws + WS_WB; bf16_t* y2 = (bf16_t*)(p.ws + WS_H);
    LAS unsigned char* img = lds + wv * 16384;
    LAS unsigned char* aux = lds + 131072 + wv * 1024;
    const int swz = (4 * kg + (li >> 2)) & 7;
    const int rd0 = (8 * kg + (li >> 1)) * 128 + 8 * (li & 1);
    const Split sp = split(tid);
    for (int xs = sp.xs0; xs < sp.xs1; ++xs) {
        const unsigned char* V8 = p.ws + WS_PV + (size_t)xs * SHARD_BYTES;
        v4u I[2]; v2u_t W[4];
        unsigned ra[8];
#pragma unroll
        for (int db = 0; db < 8; ++db) ra[db] = (unsigned)(size_t)img + rd0 + ((db ^ swz) << 4);
#define V_TC(tk) ((tk) < T ? (tk) : T - 1)
#define V_DMA_IDS(tk, buf) __builtin_amdgcn_global_load_lds((const unsigned*)(ids8 + (size_t)V_TC(tk) * 256 + lane * 4), (LAS unsigned*)(aux + (buf) * 256), 4, 0, 0)
#define V_DMA_W(tk, buf) __builtin_amdgcn_global_load_lds((const unsigned*)(w8 + (size_t)V_TC(tk) * 256 + lane * 4), (LAS unsigned*)(aux + 512 + (buf) * 256), 4, 0, 0)
#define V_RD_IDS(buf) do { I[0] = *(const LAS v4u*)(aux + (buf) * 256 + r * 32); I[1] = *(const LAS v4u*)(aux + (buf) * 256 + r * 32 + 16); } while (0)
#define V_RD_W(buf) do { _Pragma("unroll") for (int eb = 0; eb < 4; ++eb) { W[eb] = *(const LAS v2u_t*)(aux + 512 + (buf) * 256 + 128 * (li & 1) + 32 * eb + 8 * kg); } } while (0)
#define V_DMA(eb) do { _Pragma("unroll") for (int q = 0; q < 4; ++q) { const int j_ = 4 * (eb) + q; const unsigned id_ = (I[j_ >> 3][(j_ >> 1) & 3] >> (16 * (j_ & 1))) & 0xffffu; \
            __builtin_amdgcn_global_load_lds((const unsigned*)(V8 + (size_t)id_ * 128 + ((pc ^ ((4 * q + (lane >> 4)) & 7)) << 4)), (LAS unsigned*)(img + (eb) * 4096 + q * 1024), 16, 0, 0); } } while (0)
#define V_L64(q) ((long)(((unsigned long long)(q).y << 32) | (unsigned long long)(q).x))
#define V_VM(n) asm volatile("s_waitcnt vmcnt(" #n ")" ::: "memory")
#define V_STEP(tk, par) do { \
        V_VM(16); \
        V_RD_IDS((par) ^ 1); V_RD_W(par);                                            \
        asm volatile("s_waitcnt lgkmcnt(0)" ::: "memory"); \
        V_DMA_IDS((tk) + 2 * nq, par); V_DMA_W((tk) + nq, (par) ^ 1); \
        f32x4 acc[8]; \
        _Pragma("unroll") for (int db = 0; db < 8; ++db) acc[db] = (f32x4){0.f, 0.f, 0.f, 0.f}; \
        _Pragma("unroll") for (int eb = 0; eb < 4; ++eb) { long b_[8]; \
            V_VM(14); \
            _Pragma("unroll") for (int db = 0; db < 8; ++db) asm volatile("ds_read_b64_tr_b8 %0, %1 offset:%2" : "=v"(b_[db]) : "v"(ra[db]), "n"(eb * 4096) : "memory"); \
            asm volatile("s_waitcnt lgkmcnt(0)" : "+v"(b_[0]), "+v"(b_[1]), "+v"(b_[2]), "+v"(b_[3]), "+v"(b_[4]), "+v"(b_[5]), "+v"(b_[6]), "+v"(b_[7]) :: "memory"); \
            _Pragma("unroll") for (int db = 0; db < 8; ++db) acc[db] = __builtin_amdgcn_mfma_f32_16x16x32_fp8_fp8(V_L64(W[eb]), b_[db], acc[db], 0, 0, 0); \
            asm volatile("s_waitcnt lgkmcnt(0)" ::: "memory");                       \
            V_DMA(eb); } \
        float o0_ = acc[0][0] + acc[0][1], o1_ = acc[4][0] + acc[4][1];              \
        _Pragma("unroll") for (int q_ = 1; q_ < 4; ++q_) { o0_ = (kg == q_) ? acc[q_][0] + acc[q_][1] : o0_; o1_ = (kg == q_) ? acc[4 + q_][0] + acc[4 + q_][1] : o1_; } \
        { bf16_t* yp_ = y2 + (size_t)V_TC(tk) * D + xs * 128 + li; yp_[16 * kg] = f2bf(o0_ * (1.f / 4096.f)); yp_[16 * (4 + kg)] = f2bf(o1_ * (1.f / 4096.f)); } } while (0)
        const int nq = sp.nq;
        V_DMA_IDS(sp.q, 0); V_DMA_W(sp.q, 0);
        V_VM(0);
        V_RD_IDS(0);
        asm volatile("s_waitcnt lgkmcnt(0)" ::: "memory");
        V_DMA_IDS(sp.q + nq, 1);
        V_DMA(0); V_DMA(1); V_DMA(2); V_DMA(3);
        { unsigned* dmy = (unsigned*)(p.ws + 500 * MiB) + (size_t)(blockIdx.x * NWAVE + wv) * 128 + lane; dmy[0] = 0u; dmy[64] = 0u; }
        for (int t = sp.q; t < T; t += 2 * nq) { V_STEP(t, 0); V_STEP(t + nq, 1); }
        V_VM(0);
#undef V_TC
#undef V_DMA_IDS
#undef V_DMA_W
#undef V_RD_IDS
#undef V_RD_W
#undef V_DMA
#undef V_L64
#undef V_VM
#undef V_STEP
    }
}
__device__ __forceinline__ void final_phase(const Params& p) {
    const int tid = otid(), lane = tid & 63, wave = tid >> 6;
    const float* mod = (const float*)(p.ws + WS_MOD); const bf16_t* x1 = (const bf16_t*)(p.ws + WS_X1); const bf16_t* y2 = (const bf16_t*)(p.ws + WS_H);
    constexpr int RW = 4;
    const int rpb = (T + gridDim.x - 1) / gridDim.x, r0 = blockIdx.x * rpb, r1 = (r0 + rpb < T) ? r0 + rpb : T;
    int cb = -1; f32x4 gc[4];
    for (int t0 = r0 + wave; t0 < r1; t0 += NWAVE * RW) {
        uint2 xa[RW][4], za[RW][4];
#pragma unroll
        for (int i = 0; i < RW; ++i) { const int t = t0 + i * NWAVE < r1 ? t0 + i * NWAVE : t0;
#pragma unroll
            for (int j = 0; j < 4; ++j) { xa[i][j] = *(const uint2*)(x1 + (size_t)t * D + lane * 4 + 256 * j); za[i][j] = *(const uint2*)(y2 + (size_t)t * D + lane * 4 + 256 * j); } }
#pragma unroll
        for (int i = 0; i < RW; ++i) { const int t = t0 + i * NWAVE; if (t < r1) {
            const int bb = __builtin_amdgcn_readfirstlane(t / S);
            if (bb != cb) { cb = bb; const float* mb = mod + bb * 6144;
#pragma unroll
                for (int j = 0; j < 4; ++j) { const int col = lane * 4 + 256 * j; gc[j] = *(const f32x4*)(p.g_post_ffn + col) * *(const f32x4*)(mb + 5120 + col); } }
            f32x4 xv[4], zv[4]; float s2 = 0.f;
#pragma unroll
            for (int j = 0; j < 4; ++j) { const uint2 xw = xa[i][j], zw = za[i][j];
                xv[j] = (f32x4){__uint_as_float(xw.x << 16), __uint_as_float(xw.x & 0xffff0000u), __uint_as_float(xw.y << 16), __uint_as_float(xw.y & 0xffff0000u)};
                zv[j] = (f32x4){__uint_as_float(zw.x << 16), __uint_as_float(zw.x & 0xffff0000u), __uint_as_float(zw.y << 16), __uint_as_float(zw.y & 0xffff0000u)};
                s2 += zv[j][0] * zv[j][0] + zv[j][1] * zv[j][1] + zv[j][2] * zv[j][2] + zv[j][3] * zv[j][3]; }
            s2 = wave_sum(s2); const float r2 = rsqrtf(s2 * (1.f / D) + EPS);
#pragma unroll
            for (int j = 0; j < 4; ++j) { const int col = lane * 4 + 256 * j; *(f32x4*)(p.out + (size_t)t * D + col) = xv[j] + zv[j] * r2 * gc[j]; }
        } }
    }
}
}

#define GAS __attribute__((address_space(1)))
typedef GAS unsigned gu32;
#define RLX_AGENT __ATOMIC_RELAXED, __HIP_MEMORY_SCOPE_AGENT
#define XB_TMO      128
#define XB_XCNT(j)  (256  + 64 * (j))
#define XB_XSUB(j)  (1280 + 64 * (j))
#define XB_XGEN(j)  (2304 + 64 * (j))
#define XB_TOP      3328
#define XB_TOPGEN   3392
#define XCD_BAR_WORDS 3456
#define XB_SPIN_CAP (1u << 18)

__device__ __forceinline__ unsigned xb_ld(unsigned* p)              { return __hip_atomic_load(p, __ATOMIC_RELAXED, __HIP_MEMORY_SCOPE_AGENT); }
__device__ __forceinline__ unsigned xb_add(unsigned* p, unsigned v) { return __hip_atomic_fetch_add(p, v, __ATOMIC_RELAXED, __HIP_MEMORY_SCOPE_AGENT); }
__device__ __forceinline__ unsigned xb_xcc_id() { return (unsigned)__builtin_amdgcn_s_getreg((3 << 11) | 20) & 0xFu; }
#define XB_SPIN(cond, bar) do { unsigned _sp = 0; while (cond) { __builtin_amdgcn_s_sleep(1); \
    if ((++_sp & 255u) == 0u) { if (xb_ld(&(bar)[XB_TMO])) break; if (_sp > XB_SPIN_CAP) { atomicAdd(&(bar)[XB_TMO], 1u); break; } } } } while (0)

struct XcdBarrier {
    unsigned* bar; unsigned x;
    volatile LAS unsigned* st;
};

__device__ __forceinline__ XcdBarrier xcd_barrier_post(unsigned* bar, volatile LAS unsigned* st) {
    XcdBarrier b; b.bar = bar; b.x = xb_xcc_id(); b.st = st;
    if (threadIdx.x == 0) (void)xb_add(&bar[XB_XCNT(b.x)], 1u);
    return b;
}
__device__ __forceinline__ void xcd_barrier_complete(unsigned* bar, unsigned x, unsigned& nloc, unsigned& nx) {
    const unsigned G = gridDim.x * gridDim.y * gridDim.z;
    unsigned sum, cnt, mine, sp = 0u;
    for (;;) {
        sum = 0u; cnt = 0u; mine = 0u;
#pragma unroll
        for (unsigned j = 0; j < 16; ++j) { const unsigned c = xb_ld(&bar[XB_XCNT(j)]); sum += c; cnt += (c > 0u) ? 1u : 0u; mine = (j == x) ? c : mine; }
        if (sum == G) break;
        __builtin_amdgcn_s_sleep(1);
        if ((++sp & 255u) == 0u) { if (xb_ld(&bar[XB_TMO])) break; if (sp > XB_SPIN_CAP) { atomicAdd(&bar[XB_TMO], 1u); break; } }
    }
    nloc = mine > 0u ? mine : 1u; nx = cnt > 0u ? cnt : 1u;
}

__device__ __forceinline__ void xcd_barrier(const XcdBarrier& b) {
    asm volatile("s_waitcnt vmcnt(0)" ::: "memory");
    __syncthreads();
    if (threadIdx.x == 0) {
        unsigned* bar = b.bar;
        __builtin_amdgcn_s_waitcnt(0);
        unsigned nloc = b.st[0], nx = b.st[1];
        if (nloc == 0u) { xcd_barrier_complete(bar, b.x, nloc, nx); b.st[0] = nloc; b.st[1] = nx; }
        const unsigned old = xb_add(&bar[XB_XSUB(b.x)], 1u);
        const unsigned gen = old / nloc;
        if (old + 1u == (gen + 1u) * nloc) {
            __builtin_amdgcn_fence(__ATOMIC_RELEASE, "agent");
            asm volatile("s_waitcnt vmcnt(0)" ::: "memory");
            const unsigned og = xb_add(&bar[XB_TOP], 1u);
            const unsigned tg = og / nx;
            if (og + 1u == (tg + 1u) * nx) xb_add(&bar[XB_TOPGEN], 1u);
            else XB_SPIN(xb_ld(&bar[XB_TOPGEN]) == tg, bar);
            __builtin_amdgcn_fence(__ATOMIC_ACQUIRE, "agent");
            xb_add(&bar[XB_XGEN(b.x)], 1u);
            asm volatile("s_waitcnt vmcnt(0)" ::: "memory");
        } else {
            XB_SPIN(xb_ld(&bar[XB_XGEN(b.x)]) == gen, bar);
            __builtin_amdgcn_fence(__ATOMIC_ACQUIRE, "agent");
            asm volatile("s_waitcnt vmcnt(0)" ::: "memory");
        }
    }
    __syncthreads();
}


constexpr int MISC_OFF = LDS_BYTES - 256;
constexpr int CW_BAR = 1024;
constexpr size_t CTL_ZERO_BYTES = 32768;
static_assert((CW_BAR + XCD_BAR_WORDS) * 4 <= (int)CTL_ZERO_BYTES, "control region");
static_assert(att::L_END <= MISC_OFF && pg8::STAGE_BYTES <= MISC_OFF, "LDS map");

__device__ __forceinline__ void gemm_dispatch(const Params& p, LAS unsigned char* lds, int which) {
    unsigned char* ws = p.ws;
    if (which == 0) {
        pg8::Gemm g{(const bf16_t*)(ws + WS_H), (const bf16_t*)(ws + WS_WINT), T, NP, D / 2}; pg8::StaticOrder S_; S_.init(T, NP, gridDim.x, blockIdx.x);
        pg8::EpiI8S E{(bf16_t*)(ws + WS_PROJ), NP, (const float*)(ws + WS_S1), (const float*)(ws + WS_CS)};
        pg8::gemm_phase<pg8::EpiI8S, pg8::StaticOrder, true, true, true>(lds, g, S_, E);
    } else if (which == 1) {
        pg8::Gemm g{(const bf16_t*)(ws + WS_OCAT), (const bf16_t*)(ws + WS_WOT), T, D, D}; pg8::StaticOrder S_; S_.init(T, D, gridDim.x, blockIdx.x);
        pg8::EpiBf16S E{(bf16_t*)(ws + WS_PROJ), D, 0u, 1.f};
        pg8::gemm_phase<pg8::EpiBf16S, pg8::StaticOrder, true, true>(lds, g, S_, E);
    } else {
        pg8::Gemm g{(const bf16_t*)(ws + WS_H8), (const bf16_t*)(ws + WS_WPQT), T, 2048, D / 2}; pg8::StaticOrder S_; S_.init(T, 2048, gridDim.x, blockIdx.x);
        pg8::EpiI8S E{(bf16_t*)(ws + WS_PQ), 2048, (const float*)(ws + WS_SH), (const float*)(ws + WS_CS) + 3072};
        pg8::gemm_phase<pg8::EpiI8S, pg8::StaticOrder, true, true, true>(lds, g, S_, E);
    }
}

__global__ __launch_bounds__(NTHR, 2) void k_mega(Params p) {
    extern __shared__ __attribute__((aligned(16))) unsigned char lds_raw[];
    LAS unsigned char* lds = (LAS unsigned char*)lds_raw;
    volatile LAS unsigned* MISC = (volatile LAS unsigned*)(lds + MISC_OFF);
    if (threadIdx.x < 64) MISC[threadIdx.x] = 0u;
    __syncthreads();
    XcdBarrier bar = xcd_barrier_post((unsigned*)(p.ws + WS_CTL) + CW_BAR, MISC + 8);
    phase0(p, lds);                  xcd_barrier(bar);
    rw::norm1_phase(p, lds);         xcd_barrier(bar);
    gemm_dispatch(p, lds, 0);        xcd_barrier(bar);
    att::attn_phase(p, lds);         xcd_barrier(bar);
    gemm_dispatch(p, lds, 1);        xcd_barrier(bar);
    rw::post1_phase(p);              xcd_barrier(bar);
    gemm_dispatch(p, lds, 2);        xcd_barrier(bar);
    tk::topk_phase(p, lds);          xcd_barrier(bar);
    sh::u_phase(p);                  xcd_barrier(bar);
    sh::combine_phase(p);            xcd_barrier(bar);
    sh::v_phase(p, lds);             xcd_barrier(bar);
    sh::final_phase(p);
}

extern "C" void kernel_launch(void* const* d_in, const int* in_sizes, int n_in, void* d_out, int out_size, void* d_ws, size_t ws_size, hipStream_t stream) {
    Params p{};
    const float** pp = (const float**)&p;
    for (int i = 0; i < 21; ++i) pp[i] = (const float*)d_in[i];
    p.out = (float*)d_out; p.ws = (unsigned char*)d_ws;
    static int grid = 0;
    if (!grid) {
        (void)hipFuncSetAttribute((const void*)k_mega, hipFuncAttributeMaxDynamicSharedMemorySize, LDS_BYTES);
        int dev = 0, cus = 0, per_cu = 0; (void)hipGetDevice(&dev); (void)hipDeviceGetAttribute(&cus, hipDeviceAttributeMultiprocessorCount, dev);
        (void)hipOccupancyMaxActiveBlocksPerMultiprocessor(&per_cu, (const void*)k_mega, NTHR, LDS_BYTES);
        if (cus <= 0) cus = 256; if (per_cu < 1) per_cu = 1;
        grid = cus * 1;
    }
    (void)hipMemsetAsync((char*)d_ws + WS_CTL, 0, CTL_ZERO_BYTES, stream);
    void* args[] = {(void*)&p};
    (void)hipLaunchCooperativeKernel((const void*)k_mega, dim3(grid), dim3(NTHR), args, LDS_BYTES, stream);
}
```

```cpp
#include <hip/hip_runtime.h>
#include <stdint.h>
#include <math.h>

typedef unsigned short bf16_t;
constexpr int NB = 8, S = 4096, D = 1024, T = NB * S;
constexpr int NPROJ = 3080, NP = 3072;
constexpr float EPS = 1e-6f;
constexpr size_t MiB = 1u << 20;
constexpr size_t WS_CTL = 0;
constexpr size_t WS_SU = 256 * 1024;
constexpr size_t WS_SH = 384 * 1024;
constexpr size_t WS_MOD = 1 * MiB;
constexpr size_t WS_WF = 1 * MiB + 256 * 1024;
constexpr size_t WS_SKB = 1 * MiB + 512 * 1024;
constexpr size_t WS_LOGF = 2 * MiB;
constexpr size_t WS_CS = 3 * MiB;
constexpr size_t WS_S1 = 3 * MiB + 65536;
constexpr size_t WS_WINT = 4 * MiB;
constexpr size_t WS_WOT = 10 * MiB;
constexpr size_t WS_WPQT = 12 * MiB;
constexpr size_t WS_PU = 16 * MiB;
constexpr size_t WS_PV = 48 * MiB;
constexpr size_t WS_H = 80 * MiB;
constexpr size_t WS_PROJ = 144 * MiB;
constexpr size_t WS_X1 = 208 * MiB;
constexpr size_t WS_PQ = 272 * MiB;
constexpr size_t WS_OCAT = 400 * MiB;
constexpr size_t WS_H8 = 400 * MiB;
constexpr size_t WS_IDS = 464 * MiB;
constexpr size_t WS_WB = 472 * MiB;
constexpr size_t WS_G = 480 * MiB;

__device__ __forceinline__ float bf2f(bf16_t v) { return __uint_as_float(((unsigned)v) << 16); }
__device__ __forceinline__ bf16_t f2bf(float f) { unsigned u = __float_as_uint(f); return (bf16_t)((u + 0x7fffu + ((u >> 16) & 1u)) >> 16); }
template <int CTRL> __device__ __forceinline__ float dppf(float x) { return __builtin_bit_cast(float, __builtin_amdgcn_mov_dpp(__builtin_bit_cast(int, x), CTRL, 0xf, 0xf, true)); }
__device__ __forceinline__ unsigned lane_id() { return __builtin_amdgcn_mbcnt_hi(~0u, __builtin_amdgcn_mbcnt_lo(~0u, 0u)); }
template <int O> __device__ __forceinline__ float shx(float v) {
    if constexpr (O == 1) return dppf<0xB1>(v);
    else if constexpr (O == 2) return dppf<0x4E>(v);
    else if constexpr (O == 4) return dppf<0x141>(dppf<0x1B>(v));
    else if constexpr (O == 8) return dppf<0x128>(v);
    else if constexpr (O == 16) { auto rr = __builtin_amdgcn_permlane16_swap(__float_as_uint(v), __float_as_uint(v), false, false); return __uint_as_float((lane_id() & 16u) ? rr[0] : rr[1]); }
    else { auto rr = __builtin_amdgcn_permlane32_swap(__float_as_uint(v), __float_as_uint(v), false, false); return __uint_as_float((lane_id() & 32u) ? rr[0] : rr[1]); }
}
#define XL_RED(NAME, OP) \
__device__ __forceinline__ float row16_##NAME(float v) { v = OP(v, dppf<0xB1>(v)); v = OP(v, dppf<0x4E>(v)); v = OP(v, dppf<0x141>(v)); v = OP(v, dppf<0x128>(v)); return v; }     \
__device__ __forceinline__ float half_##NAME(float v) { v = row16_##NAME(v); auto s = __builtin_amdgcn_permlane16_swap(__float_as_uint(v), __float_as_uint(v), false, false); return OP(__uint_as_float(s[0]), __uint_as_float(s[1])); }     \
__device__ __forceinline__ float wave_##NAME(float v) { v = half_##NAME(v); auto t = __builtin_amdgcn_permlane32_swap(__float_as_uint(v), __float_as_uint(v), false, false); return OP(__uint_as_float(t[0]), __uint_as_float(t[1])); }
__device__ __forceinline__ float xl_add(float a, float b) { return a + b; }
XL_RED(sum, xl_add)
XL_RED(max, fmaxf)
XL_RED(min, fminf)
#undef XL_RED

__device__ __forceinline__ int t5_bucket(int dist) {
    if (dist < 16) return dist;
    float nf = (float)(dist < 1 ? 1 : dist);
    int large = 16 + (int)(logf(nf / 16.f) / logf(128.f / 16.f) * 16.f);
    return large < 31 ? large : 31;
}

namespace pg8 {
#define PG8_LAS __attribute__((address_space(3)))
typedef unsigned short bf16_t;
typedef short bf16x8 __attribute__((ext_vector_type(8)));
typedef float f32x4 __attribute__((ext_vector_type(4)));
typedef unsigned u32x4 __attribute__((ext_vector_type(4)));
typedef int i32x4 __attribute__((ext_vector_type(4)));
template <bool I8> struct AccT { typedef f32x4 type; };
template <> struct AccT<true> { typedef i32x4 type; };
constexpr int BM = 256, BK = 64, HALF = 128, HTB = HALF * BK * 2  , STAGE_BYTES = 8 * HTB, NXCD = 8, WGM = 8;

__host__ __device__ __forceinline__ int lds_byte(int r, int c) { const int st = (r >> 4) * 2 + (c >> 5), rr = r & 15, cc = c & 31, ob = rr * 64 + cc * 2; return st * 1024 + (ob ^ (((ob >> 9) & 1) << 5)); }
__host__ __device__ __forceinline__ void stage_rc(int b, int& R, int& C) { const int st = b / 1024, sb = b % 1024, swz = sb ^ (((sb >> 9) & 1) << 5); R = (st >> 1) * 16 + swz / 64; C = (st & 1) * 32 + (swz % 64) / 2; }
__host__ __device__ __forceinline__ int perm32(int rho) { const int n = rho >> 4, i = rho & 15; return 8 * (i >> 2) + 4 * n + (i & 3); }

struct Unit { int pm, pn; };
struct Gemm { const bf16_t* A; const bf16_t* Bt; int M, N, K; };

struct StaticOrder {
    int nM, nN, nwg, G, c;
    __host__ __device__ void init(int M, int N, int G_, int c_) { nM = M / BM; nN = N / BM; nwg = nM * nN; G = G_; c = c_; }
    __host__ __device__ bool next(int i, Unit& u) const {
        const long L = (long)i * G + c; if (L >= nwg) return false;
        int wgid = (int)L; { const int q = nwg / NXCD, r = nwg % NXCD, xcd = wgid % NXCD, off = wgid / NXCD; wgid = (xcd < r ? xcd * (q + 1) : r * (q + 1) + (xcd - r) * q) + off; }
        const int nig = WGM * nN, gid = wgid / nig, fm = gid * WGM, gsz = (nM - fm) < WGM ? (nM - fm) : WGM;
        u.pm = fm + ((wgid % nig) % gsz); u.pn = (wgid % nig) / gsz; return true;
    }
    __device__ __forceinline__ void a_ready(const Unit&) const {}
    __device__ __forceinline__ void done(const Unit&) const {}
};

__device__ __forceinline__ unsigned cvt_pk_bf16(float lo, float hi) { unsigned r; asm volatile("v_cvt_pk_bf16_f32 %0, %1, %2" : "=v"(r) : "v"(lo), "v"(hi)); return r; }
struct EpiBf16S {
    static constexpr bool PERM = true, AFTER_DRAIN = false;
    bf16_t* O; int ldc; unsigned scale_mask; float scale;
    __device__ __forceinline__ void operator()(const f32x4 (&acc)[2][2][4][2], const Unit& u, int wr, int wc, int fr, int fq) const {
        const int row0 = u.pm * BM + wr * 64 + fr; const int col0 = u.pn * BM + wc * 32 + 8 * fq;
        const float sc = ((scale_mask >> u.pn) & 1u) ? scale : 1.f;
#pragma unroll
        for (int ai = 0; ai < 2; ++ai)
#pragma unroll
            for (int m = 0; m < 4; ++m) { bf16_t* rowp = O + (size_t)(row0 + ai * HALF + m * 16) * ldc + col0;
#pragma unroll
                for (int bj = 0; bj < 2; ++bj) { f32x4 v0 = acc[ai][bj][m][0] * sc, v1 = acc[ai][bj][m][1] * sc;
                    u32x4 w; w.x = cvt_pk_bf16(v0[0], v0[1]); w.y = cvt_pk_bf16(v0[2], v0[3]); w.z = cvt_pk_bf16(v1[0], v1[1]); w.w = cvt_pk_bf16(v1[2], v1[3]);
                    *(u32x4*)(rowp + bj * HALF) = w; } }
    }
};
struct EpiI8S {
    static constexpr bool PERM = true, AFTER_DRAIN = false;
    bf16_t* O; int ldc; const float* rs; const float* cs;
    __device__ __forceinline__ void operator()(const i32x4 (&acc)[2][2][4][2], const Unit& u, int wr, int wc, int fr, int fq) const {
        const int row0 = u.pm * BM + wr * 64 + fr; const int col0 = u.pn * BM + wc * 32 + 8 * fq;
        f32x4 c0[2], c1[2];
#pragma unroll
        for (int bj = 0; bj < 2; ++bj) { c0[bj] = *(const f32x4*)(cs + col0 + bj * HALF); c1[bj] = *(const f32x4*)(cs + col0 + bj * HALF + 4); }
#pragma unroll
        for (int ai = 0; ai < 2; ++ai)
#pragma unroll
            for (int m = 0; m < 4; ++m) { const int r = row0 + ai * HALF + m * 16; bf16_t* rowp = O + (size_t)r * ldc + col0; const float sr = rs[r];
#pragma unroll
                for (int bj = 0; bj < 2; ++bj) { const f32x4 v0 = __builtin_convertvector(acc[ai][bj][m][0], f32x4) * sr * c0[bj], v1 = __builtin_convertvector(acc[ai][bj][m][1], f32x4) * sr * c1[bj];
                    u32x4 w; w.x = cvt_pk_bf16(v0[0], v0[1]); w.y = cvt_pk_bf16(v0[2], v0[3]); w.z = cvt_pk_bf16(v1[0], v1[1]); w.w = cvt_pk_bf16(v1[2], v1[3]);
                    *(u32x4*)(rowp + bj * HALF) = w; } }
    }
};
struct EpiF32 {
    static constexpr bool PERM = false, AFTER_DRAIN = false;
    float* O; int ldc;
    __device__ __forceinline__ void operator()(const f32x4 (&acc)[2][2][4][2], const Unit& u, int wr, int wc, int fr, int fq) const {
        const int col0 = u.pn * BM + wc * 32 + 4 * fq;
#pragma unroll
        for (int ai = 0; ai < 2; ++ai)
#pragma unroll
            for (int m = 0; m < 4; ++m) { float* rowp = O + (size_t)(u.pm * BM + ai * HALF + wr * 64 + m * 16 + fr) * ldc + col0;
#pragma unroll
                for (int bj = 0; bj < 2; ++bj)
#pragma unroll
                    for (int n = 0; n < 2; ++n) *(f32x4*)(rowp + bj * HALF + n * 16) = acc[ai][bj][m][n]; }
    }
};

template <class Epi, class Sched, bool ALIGN_EPI = false, bool SP2 = false, bool I8 = false>
__device__ __forceinline__ void gemm_phase(PG8_LAS unsigned char* lds, const Gemm g, const Sched& S, const Epi& E) {
    int tid_ = threadIdx.x; asm volatile("" : "+v"(tid_));
    const int tid = tid_, wid = __builtin_amdgcn_readfirstlane(tid >> 6), lane = tid & 63, wr = wid >> 2, wc = wid & 3, fr = lane & 15, fq = lane >> 4;
    const int K = g.K, nt = K / BK;
    unsigned voffA[2], voffB[2];
#pragma unroll
    for (int i = 0; i < 2; ++i) { int R, C; stage_rc(tid * 16 + i * 8192, R, C); const int Rb = Epi::PERM ? ((R & ~31) + perm32(R & 31)) : R;
        voffA[i] = (unsigned)(R * K + C) * 2u; voffB[i] = (unsigned)(Rb * K + C) * 2u; }
    const size_t kstep = (size_t)(BK * 2);
    const size_t hstep = (size_t)HALF * K * 2;
    const size_t tstep = 2 * hstep;
    const unsigned ldsw = (unsigned)wid * 1024u;
    const int aoff = lds_byte(wr * 64 + fr, fq * 8), boff = lds_byte(wc * 32 + fr, fq * 8);
#define PG8_SA(b, h) (((b) * 2 + (h)) * HTB)
#define PG8_SB(b, h) ((4 + (b) * 2 + (h)) * HTB)
#define PG8_STAGE(bufoff, gbase, voff) do { _Pragma("unroll") for (int _i = 0; _i < 2; ++_i) \
        __builtin_amdgcn_global_load_lds((const unsigned*)((const char*)(gbase) + (voff)[_i]), (PG8_LAS unsigned*)(lds + (bufoff) + ldsw + _i * 8192), 16, 0, 0); } while (0)
#define PG8_LDA(dst, b, h) do { _Pragma("unroll") for (int m = 0; m < 4; ++m) _Pragma("unroll") for (int k = 0; k < 2; ++k) dst[m][k] = *(const PG8_LAS bf16x8*)(lds + PG8_SA(b, h) + aoff + m * 2048 + k * 1024); } while (0)
#define PG8_LDB(dst, b, h) do { _Pragma("unroll") for (int n = 0; n < 2; ++n) _Pragma("unroll") for (int k = 0; k < 2; ++k) dst[n][k] = *(const PG8_LAS bf16x8*)(lds + PG8_SB(b, h) + boff + n * 2048 + k * 1024); } while (0)
#define PG8_MMA(ai, bj, At, Bt) do { __builtin_amdgcn_s_setprio(1); _Pragma("unroll") for (int m = 0; m < 4; ++m) _Pragma("unroll") for (int n = 0; n < 2; ++n) _Pragma("unroll") for (int k = 0; k < 2; ++k) \
        { if constexpr (I8) acc[ai][bj][m][n] = __builtin_amdgcn_mfma_i32_16x16x64_i8(__builtin_bit_cast(i32x4, Bt[n][k]), __builtin_bit_cast(i32x4, At[m][k]), acc[ai][bj][m][n], 0, 0, 0); \
          else acc[ai][bj][m][n] = __builtin_amdgcn_mfma_f32_16x16x32_bf16(Bt[n][k], At[m][k], acc[ai][bj][m][n], 0, 0, 0); } __builtin_amdgcn_s_setprio(0); } while (0)
#define PG8_WAIT_V(n) asm volatile("s_waitcnt vmcnt(" #n ")" ::: "memory")
#define PG8_WAIT_L(n) asm volatile("s_waitcnt lgkmcnt(" #n ")" ::: "memory")
#define PG8_BAR __builtin_amdgcn_s_barrier()
#define PG8_SCHED __builtin_amdgcn_sched_barrier(0)
    Unit cur, nxt; int ui = 0;
    if (!S.next(0, cur)) return;
    typedef typename AccT<I8>::type acc_t;
    acc_t acc[2][2][4][2];
#pragma unroll
    for (int a = 0; a < 2; ++a)
#pragma unroll
        for (int b = 0; b < 2; ++b)
#pragma unroll
            for (int m = 0; m < 4; ++m)
#pragma unroll
                for (int n = 0; n < 2; ++n) acc[a][b][m][n] = (acc_t){0, 0, 0, 0};
    bf16x8 At[4][2], B0[2][2], B1[2][2];
    const char* cA = (const char*)g.A + (size_t)cur.pm * tstep; const char* cB = (const char*)g.Bt + (size_t)cur.pn * tstep;
    S.a_ready(cur);
    if constexpr (SP2) {
        PG8_STAGE(PG8_SB(0, 0), cB, voffB); PG8_STAGE(PG8_SB(0, 1), cB + hstep, voffB); PG8_STAGE(PG8_SA(0, 0), cA, voffA); PG8_STAGE(PG8_SA(0, 1), cA + hstep, voffA);
        if (wr == 1) PG8_BAR;
        PG8_WAIT_V(2); PG8_BAR;
        PG8_STAGE(PG8_SB(1, 0), cB + kstep, voffB); PG8_STAGE(PG8_SA(1, 0), cA + kstep, voffA); PG8_STAGE(PG8_SB(1, 1), cB + hstep + kstep, voffB);
        PG8_WAIT_V(6); PG8_BAR;
    } else {
        PG8_STAGE(PG8_SB(0, 0), cB, voffB); PG8_STAGE(PG8_SA(0, 0), cA, voffA); PG8_STAGE(PG8_SB(0, 1), cB + hstep, voffB); PG8_STAGE(PG8_SA(0, 1), cA + hstep, voffA);
        if (wr == 1) PG8_BAR;
        PG8_WAIT_V(4); PG8_BAR;
        PG8_STAGE(PG8_SB(1, 0), cB + kstep, voffB); PG8_STAGE(PG8_SA(1, 0), cA + kstep, voffA); PG8_STAGE(PG8_SB(1, 1), cB + hstep + kstep, voffB);
        PG8_WAIT_V(6); PG8_BAR;
    }
    for (;;) {
        const bool has_next = S.next(ui + 1, nxt);
        const char* nA = has_next ? (const char*)g.A + (size_t)nxt.pm * tstep : cA; const char* nB = has_next ? (const char*)g.Bt + (size_t)nxt.pn * tstep : cB;
        for (int t = 0; t < nt; t += 2) {
            const bool last = (t == nt - 2);
            const char* a1 = cA + (size_t)(t + 1) * kstep;
            const char* a2 = last ? nA : cA + (size_t)(t + 2) * kstep; const char* b2 = last ? nB : cB + (size_t)(t + 2) * kstep;
            const char* a3 = a2 + kstep; const char* b3 = b2 + kstep;
            if (last && has_next) S.a_ready(nxt);
            if constexpr (SP2) {
            PG8_LDB(B0, 0, 0); PG8_LDB(B1, 0, 1); PG8_SCHED; PG8_LDA(At, 0, 0); PG8_STAGE(PG8_SA(1, 1), a1 + hstep, voffA);
            PG8_WAIT_V(8); PG8_WAIT_L(0); PG8_BAR; PG8_MMA(0, 0, At, B0); PG8_MMA(0, 1, At, B1); PG8_BAR; PG8_SCHED;
            PG8_LDA(At, 0, 1); PG8_STAGE(PG8_SB(0, 0), b2, voffB); PG8_STAGE(PG8_SB(0, 1), b2 + hstep, voffB); PG8_STAGE(PG8_SA(0, 0), a2, voffA);
            PG8_WAIT_V(8); PG8_WAIT_L(0); PG8_BAR; PG8_MMA(1, 0, At, B0); PG8_MMA(1, 1, At, B1); PG8_BAR; PG8_SCHED;
            PG8_LDB(B0, 1, 0); PG8_LDB(B1, 1, 1); PG8_SCHED; PG8_LDA(At, 1, 0); PG8_STAGE(PG8_SA(0, 1), a2 + hstep, voffA);
            PG8_WAIT_V(8); PG8_WAIT_L(0); PG8_BAR; PG8_MMA(0, 0, At, B0); PG8_MMA(0, 1, At, B1); PG8_BAR; PG8_SCHED;
            PG8_LDA(At, 1, 1); PG8_STAGE(PG8_SB(1, 0), b3, voffB); PG8_STAGE(PG8_SB(1, 1), b3 + hstep, voffB); PG8_STAGE(PG8_SA(1, 0), a3, voffA);
            PG8_WAIT_V(8); PG8_WAIT_L(0); PG8_BAR; PG8_MMA(1, 0, At, B0); PG8_MMA(1, 1, At, B1); PG8_BAR; PG8_SCHED;
            } else {
            PG8_LDB(B0, 0, 0); PG8_SCHED; PG8_LDA(At, 0, 0); PG8_STAGE(PG8_SA(1, 1), a1 + hstep, voffA);
            PG8_WAIT_L(8); PG8_BAR; PG8_WAIT_L(0); PG8_MMA(0, 0, At, B0); PG8_BAR; PG8_SCHED;
            PG8_LDB(B1, 0, 1); PG8_STAGE(PG8_SB(0, 0), b2, voffB);
            PG8_BAR; PG8_WAIT_L(0); PG8_MMA(0, 1, At, B1); PG8_BAR;
            PG8_LDA(At, 0, 1); PG8_STAGE(PG8_SA(0, 0), a2, voffA);
            PG8_BAR; PG8_WAIT_L(0); PG8_MMA(1, 0, At, B0); PG8_BAR; PG8_SCHED;
            PG8_STAGE(PG8_SB(0, 1), b2 + hstep, voffB);
            PG8_WAIT_V(6); PG8_BAR; PG8_MMA(1, 1, At, B1); PG8_BAR;
            PG8_LDB(B0, 1, 0); PG8_SCHED; PG8_LDA(At, 1, 0); PG8_STAGE(PG8_SA(0, 1), a2 + hstep, voffA);
            PG8_WAIT_L(8); PG8_BAR; PG8_WAIT_L(0); PG8_MMA(0, 0, At, B0); PG8_BAR; PG8_SCHED;
            PG8_LDB(B1, 1, 1); PG8_STAGE(PG8_SB(1, 0), b3, voffB);
            PG8_BAR; PG8_WAIT_L(0); PG8_MMA(0, 1, At, B1); PG8_BAR;
            PG8_LDA(At, 1, 1); PG8_STAGE(PG8_SA(1, 0), a3, voffA);
            PG8_BAR; PG8_WAIT_L(0); PG8_MMA(1, 0, At, B0); PG8_BAR; PG8_SCHED;
            PG8_STAGE(PG8_SB(1, 1), b3 + hstep, voffB);
            PG8_WAIT_V(6); PG8_BAR; PG8_MMA(1, 1, At, B1); PG8_BAR;
            }
        }
        if constexpr (ALIGN_EPI) { if (wr == 0) PG8_BAR; }
        if constexpr (!Epi::AFTER_DRAIN) { E(acc, cur, wr, wc, fr, fq); S.done(cur); }
        if (!has_next) break;
#pragma unroll
        for (int a = 0; a < 2; ++a)
#pragma unroll
            for (int b = 0; b < 2; ++b)
#pragma unroll
                for (int m = 0; m < 4; ++m)
#pragma unroll
                    for (int n = 0; n < 2; ++n) acc[a][b][m][n] = (acc_t){0, 0, 0, 0};
        cur = nxt; cA = nA; cB = nB; ++ui;
        if constexpr (ALIGN_EPI) { if (wr == 1) PG8_BAR; }
    }
    PG8_WAIT_V(0);
    if constexpr (!ALIGN_EPI) { if (wr == 0) PG8_BAR; }
    PG8_BAR;
    if constexpr (Epi::AFTER_DRAIN) { E.fused(acc, cur, wr, wc, fr, fq, lds, wid, lane); S.done(cur); }
#undef PG8_SA
#undef PG8_SB
#undef PG8_STAGE
#undef PG8_LDA
#undef PG8_LDB
#undef PG8_MMA
#undef PG8_WAIT_V
#undef PG8_WAIT_L
#undef PG8_BAR
#undef PG8_SCHED
}
}

#define LAS __attribute__((address_space(3)))
typedef float f32x4 __attribute__((ext_vector_type(4)));
typedef unsigned v4u __attribute__((ext_vector_type(4)));
constexpr int NTHR = 512, NWAVE = 8;
constexpr int LDS_BYTES = 147456;
constexpr float C2 = 0.125f * 1.4426950408889634f;

struct Params {
    const float *x, *c, *rel_bias, *w_ada, *b_ada, *g_pre_mix, *g_post_mix, *w_in, *b_f, *lq1, *lk1, *lq2, *lk2, *g_subln, *w_o, *g_pre_ffn, *g_post_ffn, *w_pq, *sub_keys, *peer_u, *peer_v;
    float* out; unsigned char* ws;
};
__device__ __forceinline__ int otid() { int t = threadIdx.x; asm volatile("" : "+v"(t)); return t; }
__device__ __forceinline__ unsigned pk2(float lo, float hi) { return (unsigned)f2bf(lo) | ((unsigned)f2bf(hi) << 16); }

__device__ __forceinline__ void p0_transpose_item(const float* W, int K, int N, int ldw, bf16_t* WT, LAS float* scr, int item, int lane) {
    const int nblk = N / 32, kb = item / nblk, nb = item % nblk, k0 = 64 * kb, n0 = 32 * nb;
#pragma unroll 8
    for (int i = 0; i < 32; ++i) { const int kk = 2 * i + (lane >> 5); scr[kk * 33 + (lane & 31)] = W[(size_t)(k0 + kk) * ldw + n0 + (lane & 31)]; }
    asm volatile("s_waitcnt lgkmcnt(0)" ::: "memory");
    const int c = lane & 7;
#pragma unroll
    for (int j = 0; j < 4; ++j) { const int n = (lane >> 3) + 8 * j; const LAS float* s = scr + (8 * c) * 33 + n;
        v4u o; o.x = pk2(s[0 * 33], s[1 * 33]); o.y = pk2(s[2 * 33], s[3 * 33]); o.z = pk2(s[4 * 33], s[5 * 33]); o.w = pk2(s[6 * 33], s[7 * 33]);
        *(v4u*)(WT + (size_t)(n0 + n) * K + k0 + 8 * c) = o; }
    asm volatile("s_waitcnt lgkmcnt(0)" ::: "memory");
}

__device__ __forceinline__ void p0_quant_panel(const float* W, int ldw, int n0, unsigned char* WT8, float* csout, float csmul, LAS unsigned char* lds, int tid) {
    const int lane = tid & 63, wave = tid >> 6;
    LAS float* scr = (LAS float*)(lds + wave * 17408);
    LAS float* red = (LAS float*)(lds + 8 * 17408);
#pragma unroll 8
    for (int i = 0; i < 64; ++i) { const int kk = 2 * i + (lane >> 5); scr[kk * 33 + (lane & 31)] = W[(size_t)(128 * wave + kk) * ldw + n0 + (lane & 31)]; }
    asm volatile("s_waitcnt lgkmcnt(0)" ::: "memory");
    { const int n = lane & 31, half = lane >> 5; float m = 0.f;
#pragma unroll 8
      for (int i = 0; i < 64; ++i) m = fmaxf(m, fabsf(scr[(64 * half + i) * 33 + n]));
      red[(2 * wave + half) * 32 + n] = m; }
    __syncthreads();
    const int c = lane & 7;
#pragma unroll
    for (int j = 0; j < 4; ++j) { const int n = (lane >> 3) + 8 * j; float mx = 0.f;
#pragma unroll
        for (int q = 0; q < 16; ++q) mx = fmaxf(mx, red[q * 32 + n]);
        const float sc = mx > 0.f ? mx * (1.f / 127.f) : 1.f, inv = 1.f / sc;
        if (wave == 0 && c == 0) csout[n0 + n] = sc * csmul;
        const LAS float* s_ = scr + (16 * c) * 33 + n; v4u o;
#pragma unroll
        for (int k = 0; k < 4; ++k) { const int q0 = __float2int_rn(s_[(4 * k) * 33] * inv), q1 = __float2int_rn(s_[(4 * k + 1) * 33] * inv), q2 = __float2int_rn(s_[(4 * k + 2) * 33] * inv), q3 = __float2int_rn(s_[(4 * k + 3) * 33] * inv);
            o[k] = (unsigned)(q0 & 255) | ((unsigned)(q1 & 255) << 8) | ((unsigned)(q2 & 255) << 16) | ((unsigned)(q3 & 255) << 24); }
        *(v4u*)(WT8 + (size_t)(n0 + n) * 1024 + 128 * wave + 16 * c) = o; }
    __syncthreads();
}

__device__ __forceinline__ void phase0(const Params& p, LAS unsigned char* lds) {
    const int tid = otid(), lane = tid & 63, wave = tid >> 6, G = gridDim.x, bid = blockIdx.x;
    unsigned char* ws = p.ws;
    if (bid < 192) {
        LAS float* sl = (LAS float*)lds;
        LAS float* red = (LAS float*)(lds + 32768);
        for (int i = tid; i < 8192; i += NTHR) { float v = p.c[i]; sl[i] = v / (1.f + expf(-v)); }
        __syncthreads();
      for (int ch = bid; ch < 192; ch += G) {
        const int col = tid & 31, isl = tid >> 5, c0 = ch * 32;
        float acc[8];
#pragma unroll
        for (int b = 0; b < 8; ++b) acc[b] = 0.f;
        for (int ii = 0; ii < 64; ++ii) { const int i = isl * 64 + ii; const float w = p.w_ada[(size_t)i * 6144 + c0 + col];
#pragma unroll
            for (int b = 0; b < 8; ++b) acc[b] += sl[b * 1024 + i] * w; }
#pragma unroll
        for (int b = 0; b < 8; ++b) red[(isl * 8 + b) * 32 + col] = acc[b];
        __syncthreads();
        if (tid < 256) { const int b = tid >> 5; float s = 0.f;
#pragma unroll
            for (int k = 0; k < 16; ++k) s += red[(k * 8 + b) * 32 + col];
            ((float*)(ws + WS_MOD))[b * 6144 + c0 + col] = s + p.b_ada[c0 + col]; }
        __syncthreads();
      }
    }
    for (int pn = G - 1 - bid; pn < 160; pn += G) {
        if (pn < 64) p0_quant_panel(p.w_pq, 2048, 32 * pn, ws + WS_WPQT, (float*)(ws + WS_CS) + 3072, 1.f, lds, tid);
        else { const int n0 = 32 * (pn - 64);
            p0_quant_panel(p.w_in, NPROJ, n0, ws + WS_WINT, (float*)(ws + WS_CS), (n0 < 512 || (n0 >= 1536 && n0 < 2048)) ? C2 : 1.f, lds, tid); } }
    {
        LAS float* scr = (LAS float*)(lds + wave * 16384);
        const int gw = bid * NWAVE + wave, NGW = G * NWAVE;
        constexpr int I_O = 16 * 32;
        for (int it = gw; it < I_O; it += NGW) p0_transpose_item(p.w_o, 1024, 1024, 1024, (bf16_t*)(ws + WS_WOT), scr, it, lane);
    }
    const int gt = bid * NTHR + tid, NGT = G * NTHR;
    for (int i = gt; i < 8192; i += NGT) { const int hh = i >> 10, k = i & 1023; ((float*)(ws + WS_WF))[i] = p.w_in[(size_t)k * NPROJ + NP + hh]; }
    for (int i = gt; i < 32768 / 2; i += NGT) { ((unsigned*)(ws + WS_SKB))[i] = pk2(p.sub_keys[2 * i], p.sub_keys[2 * i + 1]); }
    {
        const int gw = bid * NWAVE + wave, NGW = G * NWAVE;
        float* su = (float*)(ws + WS_SU);
        for (int e0 = gw; e0 < 16384; e0 += 2 * NGW) {
            f32x4 a[2][4];
#pragma unroll
            for (int u = 0; u < 2; ++u) { const int e = (e0 + u * NGW < 16384) ? e0 + u * NGW : e0;
#pragma unroll
                for (int k = 0; k < 4; ++k) a[u][k] = *(const f32x4*)(p.peer_u + (size_t)e * 1024 + lane * 16 + 4 * k); }
#pragma unroll
            for (int u = 0; u < 2; ++u) { const int e = e0 + u * NGW; if (e < 16384) {
                float am = 0.f;
#pragma unroll
                for (int k = 0; k < 4; ++k) am = fmaxf(am, fmaxf(fmaxf(fabsf(a[u][k][0]), fabsf(a[u][k][1])), fmaxf(fabsf(a[u][k][2]), fabsf(a[u][k][3]))));
                am = wave_max(am);
                const float sc = am > 0.f ? am * (1.f / 127.f) : 1.f, inv = 1.f / sc;
                v4u o;
#pragma unroll
                for (int k = 0; k < 4; ++k) { const int q0 = __float2int_rn(a[u][k][0] * inv), q1 = __float2int_rn(a[u][k][1] * inv), q2 = __float2int_rn(a[u][k][2] * inv), q3 = __float2int_rn(a[u][k][3] * inv);
                    o[k] = (unsigned)(q0 & 255) | ((unsigned)(q1 & 255) << 8) | ((unsigned)(q2 & 255) << 16) | ((unsigned)(q3 & 255) << 24); }
                *(v4u*)(ws + WS_PU + (size_t)(lane >> 3) * ((size_t)16384 * 128) + (size_t)e * 128 + (lane & 7) * 16) = o;
                if (lane == 0) su[e] = sc; } }
        }
    }
    constexpr int NIT = 16384 * 64;
    for (int i0 = gt; i0 < NIT; i0 += 4 * NGT) {
        f32x4 a[4][4];
#pragma unroll
        for (int u = 0; u < 4; ++u) { const int i = (i0 + u * NGT < NIT) ? i0 + u * NGT : i0; const int e = i >> 6, cc = i & 63;
            const float* src = p.peer_v + (size_t)e * 1024 + cc * 16;
#pragma unroll
            for (int k = 0; k < 4; ++k) a[u][k] = *(const f32x4*)(src + 4 * k); }
#pragma unroll
        for (int u = 0; u < 4; ++u) { const int i = i0 + u * NGT; if (i < NIT) { const int e = i >> 6, cc = i & 63;
            unsigned char* dst = ws + WS_PV + (size_t)(cc >> 3) * ((size_t)16384 * 128) + (size_t)e * 128 + (cc & 7) * 16;
            v4u o;
#pragma unroll
            for (int k = 0; k < 4; ++k) { int w = __builtin_amdgcn_cvt_pk_fp8_f32(a[u][k][0] * 64.f, a[u][k][1] * 64.f, 0, false); w = __builtin_amdgcn_cvt_pk_fp8_f32(a[u][k][2] * 64.f, a[u][k][3] * 64.f, w, true); o[k] = (unsigned)w; }
            *(v4u*)dst = o; } }
    }
}


namespace att {
typedef short bf16x8 __attribute__((ext_vector_type(8)));
typedef float f32x16 __attribute__((ext_vector_type(16)));
typedef short s16x4 __attribute__((ext_vector_type(4)));
typedef short v4i16_t __attribute__((ext_vector_type(4)));
constexpr int L_K = 0;
constexpr int L_V = 16384;
constexpr int L_WSF = 49152;
constexpr int L_NB = 51200;
constexpr int L_TBL = 67584;
constexpr int L_SCAN = 68096;
constexpr int L_STG = 70144;
constexpr int L_END = 135680;
static_assert(L_END <= LDS_BYTES, "attention LDS map");
__device__ __forceinline__ int crow(int r, int hi) { return (r & 3) + 8 * (r >> 2) + 4 * hi; }
__device__ __forceinline__ s16x4 vtr(const LAS unsigned char* p) { return __builtin_bit_cast(s16x4, __builtin_amdgcn_ds_read_tr16_b64_v4i16((LAS v4i16_t*)p)); }
__device__ __forceinline__ float xhalf_max(float m) { auto rr = __builtin_amdgcn_permlane32_swap(__float_as_uint(m), __float_as_uint(m), false, false); return fmaxf(__uint_as_float(rr[0]), __uint_as_float(rr[1])); }
__device__ __forceinline__ float xhalf_sum(float m) { auto rr = __builtin_amdgcn_permlane32_swap(__float_as_uint(m), __float_as_uint(m), false, false); return __uint_as_float(rr[0]) + __uint_as_float(rr[1]); }

__device__ __forceinline__ float max3f(float a, float b, float c) { float r; asm("v_max3_f32 %0, %1, %2, %3" : "=v"(r) : "v"(a), "v"(b), "v"(c)); return r; }
__device__ __forceinline__ float wave_min32(float v) {
    return half_min(v);
}
constexpr float RESC_THR = 8.f;
constexpr float PRUNE_THR = 24.f;

template <int DV, int MODE>
__device__ __forceinline__ void attn_pass(f32x16 (&o)[DV / 32], const bf16_t* __restrict__ proj, int b, int q0, int qcol, int kcol, int vcol, float kmax, LAS unsigned char* lds, int tid) {
    asm volatile("" : "+v"(tid));
    const int lane = tid & 63, wid = __builtin_amdgcn_readfirstlane(tid >> 6), r32 = lane & 31, hi = lane >> 5;
    const size_t rowbase = (size_t)b * S;
    bf16x8 qr[4];
    { const bf16_t* qp = proj + (rowbase + q0 + wid * 32 + r32) * NP + qcol + hi * 8;
#pragma unroll
      for (int d0 = 0; d0 < 4; ++d0) qr[d0] = *(const bf16x8*)(qp + d0 * 16); }
    asm volatile("" : "+v"(qr[0]), "+v"(qr[1]), "+v"(qr[2]), "+v"(qr[3]));
    float qkb = 0.f;
    if (MODE == 1) { float ssq = 0.f;
#pragma unroll
        for (int d0 = 0; d0 < 4; ++d0)
#pragma unroll
            for (int j = 0; j < 8; ++j) { const float f = bf2f((bf16_t)qr[d0][j]); ssq += f * f; }
        ssq = xhalf_sum(ssq);
        float mx = ssq;
        mx = half_max(mx);
        qkb = sqrtf(mx) * kmax * 1.0001f; }
    const int srow = tid >> 3, sch = tid & 7;
    const unsigned kgo = (unsigned)(srow * NP + kcol + sch * 8) * 2u;
    const int kw = sch * 1024 + ((srow + sch) & 63) * 16;
    constexpr int NVP = DV / 64;
    unsigned vgo[NVP]; int vw[NVP];
#pragma unroll
    for (int j = 0; j < NVP; ++j) { const int i = tid + 512 * j; const int row = (DV == 64) ? (i >> 3) : (i >> 4), ch = (DV == 64) ? (i & 7) : (i & 15);
        vgo[j] = (unsigned)(row * NP + vcol + ch * 8) * 2u; vw[j] = (ch >> 2) * 4096 + (row >> 4) * 1024 + (row & 15) * 64 + (ch & 3) * 16; }
    const unsigned char* slab0 = (const unsigned char*)(proj + rowbase * NP);
    v4u kreg, vreg[NVP];
    LAS float* wsf = (LAS float*)(lds + L_WSF) + wid * 64;
    const LAS float* nb = (const LAS float*)(lds + L_NB);
    const LAS float* tbl = (const LAS float*)(lds + L_TBL);
    volatile LAS unsigned* flags = (volatile LAS unsigned*)(lds + L_SCAN + 64);
    float m = 0.f, l = 0.f; bool first = true, wdone = false;
#pragma unroll
    for (int d0 = 0; d0 < DV / 32; ++d0)
#pragma unroll
        for (int r = 0; r < 16; ++r) o[d0][r] = 0.f;
    const int NT = (q0 + 256) / 64;
    const int qw0 = q0 + wid * 32, qabs = qw0 + r32;
    { const unsigned char* sl = slab0 + (size_t)(NT - 1) * 64 * NP * 2;
      kreg = *(const v4u*)(sl + kgo);
#pragma unroll
      for (int j = 0; j < NVP; ++j) vreg[j] = *(const v4u*)(sl + vgo[j]); }
    *(LAS v4u*)(lds + L_K + kw) = kreg;
#pragma unroll
    for (int j = 0; j < NVP; ++j) *(LAS v4u*)(lds + L_V + vw[j]) = vreg[j];
    if (MODE == 1 && tid < 8) flags[tid] = 0u;
    __syncthreads();
    const int vlane = ((lane >> 4) & 1) * 32 + (lane & 3) * 8 + (4 * hi + ((lane & 15) >> 2)) * 64;
    int cur = 0;
    for (int t = NT - 1; t >= 0; --t) {
        const int s0 = t * 64;
        if (t > 0) { const unsigned char* sl = slab0 + (size_t)(s0 - 64) * NP * 2;
            kreg = *(const v4u*)(sl + kgo);
#pragma unroll
            for (int j = 0; j < NVP; ++j) vreg[j] = *(const v4u*)(sl + vgo[j]); }
        if (s0 <= qw0 + 31 && !wdone) {
            f32x16 p0, p1;
            if (MODE == 1) {
#pragma unroll
                for (int g4 = 0; g4 < 4; ++g4) { const f32x4 a = *(const LAS f32x4*)(nb + s0 + 8 * g4 + 4 * hi), c = *(const LAS f32x4*)(nb + s0 + 32 + 8 * g4 + 4 * hi);
#pragma unroll
                    for (int e = 0; e < 4; ++e) { p0[4 * g4 + e] = a[e] - m; p1[4 * g4 + e] = c[e] - m; } }
            } else {
#pragma unroll
                for (int r = 0; r < 16; ++r) { p0[r] = -m; p1[r] = -m; } }
            const LAS unsigned char* kb = lds + L_K + cur * 8192;
            { bf16x8 ka[8];
#pragma unroll
              for (int d0 = 0; d0 < 4; ++d0) { const int c = 2 * d0 + hi;
                  ka[2 * d0] = *(const LAS bf16x8*)(kb + c * 1024 + ((r32 + c) & 63) * 16);
                  ka[2 * d0 + 1] = *(const LAS bf16x8*)(kb + c * 1024 + ((r32 + 32 + c) & 63) * 16); }
#pragma unroll
              for (int d0 = 0; d0 < 4; ++d0) { p0 = __builtin_amdgcn_mfma_f32_32x32x16_bf16(ka[2 * d0], qr[d0], p0, 0, 0, 0); p1 = __builtin_amdgcn_mfma_f32_32x32x16_bf16(ka[2 * d0 + 1], qr[d0], p1, 0, 0, 0); } }
            const LAS unsigned char* vb = lds + L_V + cur * 16384 + vlane;
            constexpr int ND = DV / 32;
            s16x4 fa[ND][2][2];
#pragma unroll
            for (int d0 = 0; d0 < (ND < 2 ? ND : 2); ++d0)
#pragma unroll
                for (int i = 0; i < 2; ++i) { fa[d0][i][0] = vtr(vb + d0 * 4096 + i * 1024); fa[d0][i][1] = vtr(vb + d0 * 4096 + i * 1024 + 512); }
            const bool band = (MODE == 0) ? (s0 + 63 + 112 >= qw0) : (s0 + 63 > qw0);
            if (band) {
                int qh = qabs - 4 * hi - s0; asm volatile("" : "+v"(qh));
#pragma unroll
                for (int r = 0; r < 16; ++r) { const int d0_ = qh - ((r & 3) + 8 * (r >> 2)), d1_ = d0_ - 32;
                    if (MODE == 0) { const float b0 = tbl[d0_ < 0 ? 0 : (d0_ > 127 ? 127 : d0_)], b1 = tbl[d1_ < 0 ? 0 : (d1_ > 127 ? 127 : d1_)];
                        p0[r] = d0_ < 0 ? -INFINITY : p0[r] + b0; p1[r] = d1_ < 0 ? -INFINITY : p1[r] + b1; }
                    else { p0[r] = d0_ < 0 ? -INFINITY : p0[r]; p1[r] = d1_ < 0 ? -INFINITY : p1[r]; } }
            }
            asm volatile("s_nop 15\n\ts_nop 7" : "+v"(p0), "+v"(p1));
            float ra = max3f(p0[0], p0[1], p1[0]), rb = max3f(p0[2], p0[3], p1[1]); ra = max3f(ra, p1[2], p1[3]);
#pragma unroll
            for (int r = 4; r < 16; r += 4) { ra = max3f(ra, p0[r], p0[r + 1]); rb = max3f(rb, p0[r + 2], p0[r + 3]); ra = max3f(ra, p1[r], p1[r + 1]); rb = max3f(rb, p1[r + 2], p1[r + 3]); }
            float rm = xhalf_max(fmaxf(ra, rb));
            if (first || __any(rm > RESC_THR)) {
                const float dl = first ? rm : fmaxf(rm, 0.f), alpha = first ? 1.f : __builtin_amdgcn_exp2f(-dl);
                m += dl; l *= alpha;
#pragma unroll
                for (int r = 0; r < 16; ++r) { p0[r] -= dl; p1[r] -= dl; }
                if (!first) {
                    if (hi == 0) wsf[r32] = alpha;
                    asm volatile("s_waitcnt lgkmcnt(0)" ::: "memory");
#pragma unroll
                    for (int r = 0; r < 16; ++r) { const float f = wsf[crow(r, hi)];
#pragma unroll
                        for (int d0 = 0; d0 < DV / 32; ++d0) o[d0][r] *= f; }
                }
                first = false;
            }
            float rs = 0.f;
#pragma unroll
            for (int r = 0; r < 16; ++r) { p0[r] = __builtin_amdgcn_exp2f(p0[r]); rs += p0[r]; }
            v4u pw[4];
#pragma unroll
            for (int i = 0; i < 4; ++i) { pw[0][i] = pg8::cvt_pk_bf16(p0[2 * i], p0[2 * i + 1]); pw[1][i] = pg8::cvt_pk_bf16(p0[8 + 2 * i], p0[8 + 2 * i + 1]); }
#pragma unroll
            for (int d0 = 2; d0 < ND; ++d0)
#pragma unroll
                for (int i = 0; i < 2; ++i) { fa[d0][i][0] = vtr(vb + d0 * 4096 + i * 1024); fa[d0][i][1] = vtr(vb + d0 * 4096 + i * 1024 + 512); }
            __builtin_amdgcn_sched_barrier(0);
#pragma unroll
            for (int d0 = 0; d0 < ND; ++d0) {
#pragma unroll
                for (int i = 0; i < 2; ++i) { const s16x4 a_ = fa[d0][i][0], b_ = fa[d0][i][1]; const bf16x8 vf = (bf16x8){a_[0], a_[1], a_[2], a_[3], b_[0], b_[1], b_[2], b_[3]};
                    o[d0] = __builtin_amdgcn_mfma_f32_32x32x16_bf16(__builtin_bit_cast(bf16x8, pw[i]), vf, o[d0], 0, 0, 0); }
                __builtin_amdgcn_sched_barrier(0);
#pragma unroll
                for (int i = 0; i < 2; ++i) { fa[d0][i][0] = vtr(vb + d0 * 4096 + (2 + i) * 1024); fa[d0][i][1] = vtr(vb + d0 * 4096 + (2 + i) * 1024 + 512); }
#pragma unroll
                for (int r = d0 * (16 / ND); r < (d0 + 1) * (16 / ND); ++r) { p1[r] = __builtin_amdgcn_exp2f(p1[r]); rs += p1[r]; }
                __builtin_amdgcn_sched_barrier(0);
            }
            l += rs;
#pragma unroll
            for (int i = 0; i < 4; ++i) { pw[2][i] = pg8::cvt_pk_bf16(p1[2 * i], p1[2 * i + 1]); pw[3][i] = pg8::cvt_pk_bf16(p1[8 + 2 * i], p1[8 + 2 * i + 1]); }
#pragma unroll
            for (int d0 = 0; d0 < ND; ++d0)
#pragma unroll
                for (int i = 0; i < 2; ++i) { const s16x4 a_ = fa[d0][i][0], b_ = fa[d0][i][1]; const bf16x8 vf = (bf16x8){a_[0], a_[1], a_[2], a_[3], b_[0], b_[1], b_[2], b_[3]};
                    o[d0] = __builtin_amdgcn_mfma_f32_32x32x16_bf16(__builtin_bit_cast(bf16x8, pw[2 + i]), vf, o[d0], 0, 0, 0); }
        }
        if (t > 0) { *(LAS v4u*)(lds + L_K + (cur ^ 1) * 8192 + kw) = kreg;
#pragma unroll
            for (int j = 0; j < NVP; ++j) *(LAS v4u*)(lds + L_V + (cur ^ 1) * 16384 + vw[j]) = vreg[j]; }
        if (MODE == 1 && t > 0 && !wdone && !first && (s0 - 1 < qw0)) {
            const float ub = qkb + nb[s0 - 1];
            if (ub < wave_min32(m) - PRUNE_THR) { wdone = true; if (lane == 0) flags[wid] = 1u; }
        }
        __syncthreads();
        if (MODE == 1) { const unsigned all = flags[0] & flags[1] & flags[2] & flags[3] & flags[4] & flags[5] & flags[6] & flags[7]; if (all) break; }
        cur ^= 1;
    }
    if (MODE == 1) __syncthreads();
    l = xhalf_sum(l);
    if (hi == 0) wsf[r32] = 1.f / l;
    asm volatile("s_waitcnt lgkmcnt(0)" ::: "memory");
#pragma unroll
    for (int r = 0; r < 16; ++r) { const float f = wsf[crow(r, hi)];
#pragma unroll
        for (int d0 = 0; d0 < DV / 32; ++d0) o[d0][r] *= f; }
}

__device__ __forceinline__ void fox_kmax(const Params& p, int b, int h, LAS unsigned char* lds, int tid) {
    const bf16_t* kb = (const bf16_t*)(p.ws + WS_PROJ) + (size_t)b * S * NP + 2048 + h * 64;
    float mx = 0.f;
    for (int s = tid; s < S; s += NTHR) { float ss = 0.f;
#pragma unroll
        for (int c = 0; c < 8; ++c) { const v4u w = *(const v4u*)(kb + (size_t)s * NP + c * 8);
#pragma unroll
            for (int k = 0; k < 4; ++k) { const float f0 = __uint_as_float(w[k] << 16), f1 = __uint_as_float(w[k] & 0xffff0000u); ss += f0 * f0 + f1 * f1; } }
        mx = fmaxf(mx, ss); }
    mx = wave_max(mx);
    LAS float* sc = (LAS float*)(lds + L_SCAN);
    if ((tid & 63) == 0) sc[48 + (tid >> 6)] = mx;
    __syncthreads();
    if (tid == 0) { float v = sc[48];
        for (int w = 1; w < 8; ++w) v = fmaxf(v, sc[48 + w]);
        sc[32] = sqrtf(v); }
    __syncthreads();
}

template <int NC>
__device__ __forceinline__ void stage_store(LAS unsigned char* stg, bf16_t* gbase  , int lane) {
    asm volatile("" : "+v"(lane));
    asm volatile("s_waitcnt lgkmcnt(0)" ::: "memory");
    constexpr int CPR = NC / 8;
#pragma unroll
    for (int i = 0; i < 32 * CPR / 64; ++i) { const int idx = i * 64 + lane, row = idx / CPR, ch = idx % CPR;
        const v4u v = *(const LAS v4u*)(stg + row * (NC * 2) + ch * 16); *(v4u*)(gbase + (size_t)row * D + ch * 8) = v; }
    asm volatile("s_waitcnt lgkmcnt(0)" ::: "memory");
}

__device__ __forceinline__ void fox_unit(const Params& p, int b, int h, int qb, LAS unsigned char* lds, int tid) {
    const int lane = tid & 63, wid = __builtin_amdgcn_readfirstlane(tid >> 6), r32 = lane & 31, hi = lane >> 5;
    const int q0 = qb * 256, n = q0 + 256;
    const bf16_t* proj = (const bf16_t*)(p.ws + WS_PROJ);
    { LAS float* nbw = (LAS float*)(lds + L_NB); LAS float* sc = (LAS float*)(lds + L_SCAN);
      const float* lf = (const float*)(p.ws + WS_LOGF) + (size_t)b * S * 8 + h;
      float v[8]; float run = 0.f;
#pragma unroll
      for (int e = 0; e < 8; ++e) { const int s = tid * 8 + e; const float x = (s < n) ? lf[(size_t)s * 8] : 0.f; run += x; v[e] = run; }
      float inc = run;
      { float tot = run;
#define FX_STEP(O) { const float t_ = shx<O>(tot); if (lane & O) inc += t_; tot += t_; }
        FX_STEP(1) FX_STEP(2) FX_STEP(4) FX_STEP(8) FX_STEP(16) FX_STEP(32)
#undef FX_STEP
      }
      if (lane == 63) sc[wid] = inc;
      __syncthreads();
      float base = inc - run;
      for (int w = 0; w < wid; ++w) base += sc[w];
#pragma unroll
      for (int e = 0; e < 8; ++e) nbw[tid * 8 + e] = base + v[e];
      __syncthreads();
      const float ref = (q0 > 0) ? nbw[q0 - 1] : 0.f;
      __syncthreads();
#pragma unroll
      for (int e = 0; e < 8; ++e) nbw[tid * 8 + e] = -(base + v[e] - ref) * 1.4426950408889634f;
      __syncthreads(); }
    f32x16 o[2];
    attn_pass<64, 1>(o, proj, b, q0, 1536 + h * 64, 2048 + h * 64, 2560 + h * 64, *(const LAS float*)(lds + L_SCAN + 128), lds, tid);
    LAS unsigned char* stg = lds + L_STG + wid * 8192;
    { int sb = hi * 512 + r32 * 2; asm volatile("" : "+v"(sb));
#pragma unroll
    for (int r = 0; r < 16; ++r)
#pragma unroll
        for (int d0 = 0; d0 < 2; ++d0) *(LAS bf16_t*)(stg + sb + ((r & 3) + 8 * (r >> 2)) * 128 + d0 * 64) = f2bf(o[d0][r]); }
    stage_store<64>(stg, (bf16_t*)(p.ws + WS_OCAT) + ((size_t)b * S + q0 + wid * 32) * D + 512 + h * 64, lane);
}

__device__ __forceinline__ void diff_unit(const Params& p, int b, int h, int qb, float lam, LAS unsigned char* lds, int tid) {
    const int lane = tid & 63, wid = __builtin_amdgcn_readfirstlane(tid >> 6), r32 = lane & 31, hi = lane >> 5;
    const int q0 = qb * 256;
    const bf16_t* proj = (const bf16_t*)(p.ws + WS_PROJ);
    if (tid < 128) { LAS float* tb = (LAS float*)(lds + L_TBL); tb[tid] = (p.rel_bias[t5_bucket(tid) * 4 + h] - p.rel_bias[31 * 4 + h]) * 1.4426950408889634f; }
    __syncthreads();
    LAS unsigned char* stg = lds + L_STG + wid * 8192;
    f32x16 o[4];
    attn_pass<128, 0>(o, proj, b, q0, h * 128, 512 + h * 128, 1024 + h * 128, 0.f, lds, tid);
    { int sb = hi * 1024 + r32 * 2; asm volatile("" : "+v"(sb));
#pragma unroll
    for (int d0 = 0; d0 < 4; ++d0)
#pragma unroll
        for (int r = 0; r < 16; ++r) *(LAS bf16_t*)(stg + sb + ((r & 3) + 8 * (r >> 2)) * 256 + d0 * 64) = f2bf(o[d0][r]); }
    attn_pass<128, 0>(o, proj, b, q0, h * 128 + 64, 512 + h * 128 + 64, 1024 + h * 128, 0.f, lds, tid);
    float ss[16];
#pragma unroll
    for (int r = 0; r < 16; ++r) ss[r] = 0.f;
    int sb2 = hi * 1024 + r32 * 2; asm volatile("" : "+v"(sb2));
#pragma unroll
    for (int d0 = 0; d0 < 4; ++d0)
#pragma unroll
        for (int r = 0; r < 16; ++r) { const float a0 = bf2f(*(const LAS bf16_t*)(stg + sb2 + ((r & 3) + 8 * (r >> 2)) * 256 + d0 * 64));
            const float e0 = a0 - lam * o[d0][r]; o[d0][r] = e0; ss[r] += e0 * e0; }
#pragma unroll
    for (int r = 0; r < 16; ++r) {
        ss[r] = half_sum(ss[r]);
        ss[r] = rsqrtf(ss[r] * (1.f / 128.f) + EPS) * 0.8f; }
#pragma unroll
    for (int d0 = 0; d0 < 4; ++d0) { const float gg = p.g_subln[d0 * 32 + r32];
#pragma unroll
        for (int r = 0; r < 16; ++r) *(LAS bf16_t*)(stg + sb2 + ((r & 3) + 8 * (r >> 2)) * 256 + d0 * 64) = f2bf(o[d0][r] * ss[r] * gg); }
    stage_store<128>(stg, (bf16_t*)(p.ws + WS_OCAT) + ((size_t)b * S + q0 + wid * 32) * D + h * 128, lane);
}

__device__ __forceinline__ void attn_phase(const Params& p, LAS unsigned char* lds) {
    const int tid = otid(), lane = tid & 63, G = gridDim.x, bx = blockIdx.x;
    const int vcu = (G % 8 == 0) ? (bx % 8) * (G / 8) + bx / 8 : bx;
    const float lam = expf(wave_sum(p.lq1[lane] * p.lk1[lane])) - expf(wave_sum(p.lq2[lane] * p.lk2[lane])) + 0.2f;
    for (int slot = vcu; slot < 256; slot += G) {
        { const int bh = slot >> 3, s = slot & 7;
          for (int i = 0; i < 2; ++i) diff_unit(p, bh >> 2, bh & 3, i == 0 ? 15 - s : s, lam, lds, tid); }
        { const int bh = slot >> 2, s = slot & 3; const int b = bh >> 3, h = bh & 7;
          fox_kmax(p, b, h, lds, tid);
          for (int i = 0; i < 4; ++i) { const int qb = (i == 0) ? 15 - s : (i == 1) ? 8 + s : (i == 2) ? 7 - s : s; fox_unit(p, b, h, qb, lds, tid); } }
    }
}
}


namespace tk {
typedef short bf16x8 __attribute__((ext_vector_type(8)));
typedef float f32x16 __attribute__((ext_vector_type(16)));
constexpr int L_SK = 0;
constexpr int L_TAB = 65536;
#define TK_CE(a, b) do { const float t_ = __builtin_fmaxf(a, b); b = __builtin_fminf(a, b); a = t_; } while (0)
__device__ __forceinline__ void sort16(float (&v)[16]) {
    TK_CE(v[0], v[1]); TK_CE(v[2], v[3]); TK_CE(v[0], v[2]); TK_CE(v[1], v[3]); TK_CE(v[1], v[2]); TK_CE(v[4], v[5]); TK_CE(v[6], v[7]); TK_CE(v[4], v[6]); TK_CE(v[5], v[7]); TK_CE(v[5], v[6]); TK_CE(v[0], v[4]); TK_CE(v[2], v[6]); TK_CE(v[2], v[4]); TK_CE(v[1], v[5]); TK_CE(v[3], v[7]); TK_CE(v[3], v[5]); TK_CE(v[1], v[2]); TK_CE(v[3], v[4]); TK_CE(v[5], v[6]); TK_CE(v[8], v[9]); TK_CE(v[10], v[11]); TK_CE(v[8], v[10]); TK_CE(v[9], v[11]); TK_CE(v[9], v[10]); TK_CE(v[12], v[13]); TK_CE(v[14], v[15]); TK_CE(v[12], v[14]); TK_CE(v[13], v[15]); TK_CE(v[13], v[14]); TK_CE(v[8], v[12]); TK_CE(v[10], v[14]); TK_CE(v[10], v[12]); TK_CE(v[9], v[13]); TK_CE(v[11], v[15]); TK_CE(v[11], v[13]); TK_CE(v[9], v[10]); TK_CE(v[11], v[12]); TK_CE(v[13], v[14]); TK_CE(v[0], v[8]); TK_CE(v[4], v[12]); TK_CE(v[4], v[8]); TK_CE(v[2], v[10]); TK_CE(v[6], v[14]); TK_CE(v[6], v[10]); TK_CE(v[2], v[4]); TK_CE(v[6], v[8]); TK_CE(v[10], v[12]); TK_CE(v[1], v[9]); TK_CE(v[5], v[13]); TK_CE(v[5], v[9]); TK_CE(v[3], v[11]); TK_CE(v[7], v[15]); TK_CE(v[7], v[11]); TK_CE(v[3], v[5]); TK_CE(v[7], v[9]); TK_CE(v[11], v[13]); TK_CE(v[1], v[2]); TK_CE(v[3], v[4]); TK_CE(v[5], v[6]); TK_CE(v[7], v[8]); TK_CE(v[9], v[10]); TK_CE(v[11], v[12]); TK_CE(v[13], v[14]);
}
__device__ __forceinline__ void merge8x8(float (&v)[16]) {
    TK_CE(v[0], v[8]); TK_CE(v[4], v[12]); TK_CE(v[4], v[8]); TK_CE(v[2], v[10]); TK_CE(v[6], v[14]); TK_CE(v[6], v[10]); TK_CE(v[2], v[4]); TK_CE(v[6], v[8]); TK_CE(v[10], v[12]); TK_CE(v[1], v[9]); TK_CE(v[5], v[13]); TK_CE(v[5], v[9]); TK_CE(v[3], v[11]); TK_CE(v[7], v[15]); TK_CE(v[7], v[11]); TK_CE(v[3], v[5]); TK_CE(v[7], v[9]); TK_CE(v[11], v[13]); TK_CE(v[1], v[2]); TK_CE(v[3], v[4]); TK_CE(v[5], v[6]); TK_CE(v[7], v[8]); TK_CE(v[9], v[10]); TK_CE(v[11], v[12]); TK_CE(v[13], v[14]);
}
__device__ __forceinline__ void merge16(float (&a)[16], const float (&b)[16]) {
#pragma unroll
    for (int i = 0; i < 16; ++i) a[i] = __builtin_fmaxf(a[i], b[15 - i]);
#pragma unroll
    for (int j = 8; j > 0; j >>= 1)
#pragma unroll
        for (int i = 0; i < 16; ++i) { const int l = i ^ j; if (l > i) TK_CE(a[i], a[l]); }
}
__device__ __forceinline__ void load_q(bf16x8 (&qb)[8], const bf16_t* __restrict__ qrow) {
#pragma unroll
    for (int ks = 0; ks < 8; ++ks) qb[ks] = *(const bf16x8*)(qrow + ks * 16);
}
__device__ __forceinline__ void side_scores(f32x16 (&acc)[4], const bf16x8 (&qb)[8], const LAS unsigned char* skp, int r32, int hi) {
#pragma unroll
    for (int mt = 0; mt < 4; ++mt) {
#pragma unroll
        for (int r = 0; r < 16; ++r) acc[mt][r] = 0.f;
#pragma unroll
        for (int ks = 0; ks < 8; ++ks) { const bf16x8 a = *(const LAS bf16x8*)(skp + (2 * ks + hi) * 2048 + (32 * mt + r32) * 16);
            acc[mt] = __builtin_amdgcn_mfma_f32_32x32x16_bf16(a, qb[ks], acc[mt], 0, 0, 0); } }
}
__device__ __forceinline__ void side_top16(float (&top)[16], const f32x16 (&acc)[4], int hi) {
    float w[16];
#pragma unroll
    for (int mt = 0; mt < 4; ++mt) {
        float* dst = (mt == 0) ? top : w;
#pragma unroll
        for (int r = 0; r < 16; ++r) { const unsigned n = 32 * mt + (r & 3) + 8 * (r >> 2) + 4 * hi; dst[r] = __uint_as_float((__float_as_uint(acc[mt][r]) & ~127u) | n); }
        if (mt == 0) sort16(top); else { sort16(w); merge16(top, w); }
    }
    float a0[16], a1[16];
#pragma unroll
    for (int i = 0; i < 16; ++i) { auto rr = __builtin_amdgcn_permlane32_swap(__float_as_uint(top[i]), __float_as_uint(top[i]), false, false); a0[i] = __uint_as_float(rr[0]); a1[i] = __uint_as_float(rr[1]); }
    merge16(a0, a1);
#pragma unroll
    for (int i = 0; i < 16; ++i) top[i] = a0[i];
}

__device__ __forceinline__ void topk_phase(const Params& p, LAS unsigned char* lds) {
    const int tid = otid(), lane = tid & 63, wave = __builtin_amdgcn_readfirstlane(tid >> 6), r32 = lane & 31, hi = lane >> 5, G = gridDim.x;
    { const v4u* src = (const v4u*)(p.ws + WS_SKB);
      for (int i = tid; i < 4096; i += NTHR) { const int pp = i >> 11, n = (i >> 4) & 127, c = i & 15; *(LAS v4u*)(lds + L_SK + pp * 32768 + c * 2048 + n * 16) = src[i]; }
      __syncthreads(); }
    const bf16_t* pq = (const bf16_t*)(p.ws + WS_PQ);
    bf16_t* ids = (bf16_t*)(p.ws + WS_IDS); float* gout = (float*)(p.ws + WS_G);
    LAS unsigned char* tab = lds + L_TAB + wave * 2048 + lane * 32;
    bf16x8 q0[8], q1[8];
    { const int item0 = blockIdx.x * NWAVE + wave; if (item0 < T * 8 / 32) { const bf16_t* qrow = pq + ((size_t)item0 * 32 + r32) * 256 + hi * 8; load_q(q0, qrow); load_q(q1, qrow + 128); } }
    for (int item = blockIdx.x * NWAVE + wave; item < T * 8 / 32; item += G * NWAVE) {
        const size_t row = (size_t)item * 32 + r32;
        float s0[16], s1[16];
        { f32x16 acc[4]; side_scores(acc, q0, lds + L_SK, r32, hi); side_top16(s0, acc, hi); }
        { f32x16 acc[4]; side_scores(acc, q1, lds + L_SK + 32768, r32, hi);
          { const int nxt = item + G * NWAVE; const int ic = nxt < T * 8 / 32 ? nxt : item;
            const bf16_t* qrow = pq + ((size_t)ic * 32 + r32) * 256 + hi * 8; load_q(q0, qrow); load_q(q1, qrow + 128); }
          side_top16(s1, acc, hi); }
#pragma unroll
        for (int i = 0; i < 16; i += 4) {
            *(LAS unsigned*)(tab + i) = (__float_as_uint(s0[i]) & 127u) | ((__float_as_uint(s0[i + 1]) & 127u) << 8) | ((__float_as_uint(s0[i + 2]) & 127u) << 16) | ((__float_as_uint(s0[i + 3]) & 127u) << 24);
            *(LAS unsigned*)(tab + 16 + i) = (__float_as_uint(s1[i]) & 127u) | ((__float_as_uint(s1[i + 1]) & 127u) << 8) | ((__float_as_uint(s1[i + 2]) & 127u) << 16) | ((__float_as_uint(s1[i + 3]) & 127u) << 24); }
        float c0[16], c1[16], c2[16], c3[16];
#define TK_C(i, j) __uint_as_float((__float_as_uint(s0[i] + s1[j]) & ~255u) | (unsigned)((i) * 16 + (j)))
        c0[0] = TK_C(0, 0); c0[1] = TK_C(0, 1); c0[2] = TK_C(0, 2); c0[3] = TK_C(0, 3); c0[4] = TK_C(0, 4); c0[5] = TK_C(0, 5); c0[6] = TK_C(0, 6); c0[7] = TK_C(0, 7);
        c0[8] = TK_C(0, 8); c0[9] = TK_C(0, 9); c0[10] = TK_C(0, 10); c0[11] = TK_C(0, 11); c0[12] = TK_C(0, 12); c0[13] = TK_C(0, 13); c0[14] = TK_C(0, 14); c0[15] = TK_C(0, 15);
        c1[0] = TK_C(1, 0); c1[1] = TK_C(1, 1); c1[2] = TK_C(1, 2); c1[3] = TK_C(1, 3); c1[4] = TK_C(1, 4); c1[5] = TK_C(1, 5); c1[6] = TK_C(1, 6); c1[7] = TK_C(1, 7);
        c1[8] = TK_C(8, 0); c1[9] = TK_C(9, 0); c1[10] = TK_C(10, 0); c1[11] = TK_C(11, 0); c1[12] = TK_C(12, 0); c1[13] = TK_C(13, 0); c1[14] = TK_C(14, 0); c1[15] = TK_C(15, 0);
        c2[0] = TK_C(2, 0); c2[1] = TK_C(2, 1); c2[2] = TK_C(2, 2); c2[3] = TK_C(2, 3); c2[4] = TK_C(2, 4); c2[5] = TK_C(3, 0); c2[6] = TK_C(3, 1); c2[7] = TK_C(3, 2);
        c2[8] = TK_C(3, 3); c2[9] = TK_C(4, 0); c2[10] = TK_C(4, 1); c2[11] = TK_C(4, 2); c2[12] = TK_C(5, 0); c2[13] = TK_C(5, 1); c2[14] = TK_C(6, 0); c2[15] = TK_C(6, 1);
        c3[0] = TK_C(7, 0); c3[1] = TK_C(7, 1);
#pragma unroll
        for (int i = 2; i < 16; ++i) c3[i] = -INFINITY;
#undef TK_C
        merge8x8(c1); merge16(c0, c1); sort16(c2); merge16(c2, c3); merge16(c0, c2);
        float e[16], sum = 0.f;
#pragma unroll
        for (int k = 0; k < 16; ++k) { e[k] = __expf(c0[k] - c0[0]); sum += e[k]; }
        const float inv = 1.f / sum;
        unsigned idv[16];
#pragma unroll
        for (int k = 0; k < 16; ++k) { const unsigned ij = __float_as_uint(c0[k]) & 255u; const unsigned n0 = *(const LAS unsigned char*)(tab + (ij >> 4)), n1 = *(const LAS unsigned char*)(tab + 16 + (ij & 15u)); idv[k] = n0 * 128u + n1; }
        if (hi == 0) {
#pragma unroll
            for (int k = 0; k < 16; k += 8) *(v4u*)(ids + row * 16 + k) = (v4u){idv[k] | (idv[k + 1] << 16), idv[k + 2] | (idv[k + 3] << 16), idv[k + 4] | (idv[k + 5] << 16), idv[k + 6] | (idv[k + 7] << 16)};
#pragma unroll
            for (int k = 0; k < 16; k += 4) *(f32x4*)(gout + row * 16 + k) = (f32x4){e[k] * inv, e[k + 1] * inv, e[k + 2] * inv, e[k + 3] * inv};
        }
    }
}
}


namespace rw {
typedef __bf16 bf16x2 __attribute__((ext_vector_type(2)));
__device__ __forceinline__ float dot2(unsigned a, unsigned b, float c) { return __builtin_amdgcn_fdot2_f32_bf16(__builtin_bit_cast(bf16x2, a), __builtin_bit_cast(bf16x2, b), c, false); }

constexpr int RW = 4;
__device__ __forceinline__ f32x4 bf4(uint2 w) { return (f32x4){__uint_as_float(w.x << 16), __uint_as_float(w.x & 0xffff0000u), __uint_as_float(w.y << 16), __uint_as_float(w.y & 0xffff0000u)}; }
__device__ __forceinline__ void norm1_phase(const Params& p, LAS unsigned char* lds) {
    const int tid = otid(), lane = tid & 63, wave = tid >> 6;
    const float* mod = (const float*)(p.ws + WS_MOD);
    unsigned char* hout = p.ws + WS_H; float* logf_ = (float*)(p.ws + WS_LOGF);
    { const f32x4* src = (const f32x4*)(p.ws + WS_WF); LAS f32x4* dst = (LAS f32x4*)lds; for (int i = tid; i < 2048; i += NTHR) dst[i] = src[i]; }
    __syncthreads();
    const LAS float* wf = (const LAS float*)lds;
    const int rpb = (T + gridDim.x - 1) / gridDim.x, r0 = blockIdx.x * rpb, r1 = (r0 + rpb < T) ? r0 + rpb : T;
    int cb = -1; f32x4 ga[4], sh[4];
    for (int t0 = r0 + wave; t0 < r1; t0 += NWAVE * RW) {
        f32x4 xv[RW][4];
#pragma unroll
        for (int i = 0; i < RW; ++i) { const int t = t0 + i * NWAVE < r1 ? t0 + i * NWAVE : t0;
#pragma unroll
            for (int j = 0; j < 4; ++j) xv[i][j] = *(const f32x4*)(p.x + (size_t)t * D + lane * 4 + 256 * j); }
#pragma unroll
        for (int i = 0; i < RW; ++i) { const int t = t0 + i * NWAVE; if (t < r1) {
            const int bb = __builtin_amdgcn_readfirstlane(t / S);
            if (bb != cb) { cb = bb; const float* mb = mod + bb * 6144;
#pragma unroll
                for (int j = 0; j < 4; ++j) { const int col = lane * 4 + 256 * j; ga[j] = *(const f32x4*)(p.g_pre_mix + col) * (*(const f32x4*)(mb + 1024 + col) + 1.f); sh[j] = *(const f32x4*)(mb + col); } }
            f32x4 (&v)[4] = xv[i]; float ss = 0.f;
#pragma unroll
            for (int j = 0; j < 4; ++j) ss += v[j][0] * v[j][0] + v[j][1] * v[j][1] + v[j][2] * v[j][2] + v[j][3] * v[j][3];
            ss = wave_sum(ss); const float r = rsqrtf(ss * (1.f / D) + EPS);
            float am = 0.f;
#pragma unroll
            for (int j = 0; j < 4; ++j) { v[j] = v[j] * r * ga[j] + sh[j]; am = fmaxf(am, fmaxf(fmaxf(fabsf(v[j][0]), fabsf(v[j][1])), fmaxf(fabsf(v[j][2]), fabsf(v[j][3])))); }
            am = wave_max(am);
            { const float qs = am > 0.f ? am * (1.f / 127.f) : 1.f, qi = 1.f / qs;
#pragma unroll
              for (int j = 0; j < 4; ++j) { const int col = lane * 4 + 256 * j; const int q0 = __float2int_rn(v[j][0] * qi), q1 = __float2int_rn(v[j][1] * qi), q2 = __float2int_rn(v[j][2] * qi), q3 = __float2int_rn(v[j][3] * qi);
                  *(unsigned*)(hout + (size_t)t * D + col) = (unsigned)(q0 & 255) | ((unsigned)(q1 & 255) << 8) | ((unsigned)(q2 & 255) << 16) | ((unsigned)(q3 & 255) << 24); }
              if (lane == 0) ((float*)(p.ws + WS_S1))[t] = qs; }
            float d8[8];
#pragma unroll
            for (int hq = 0; hq < 4; ++hq) {
#pragma unroll
                for (int h2_ = 0; h2_ < 2; ++h2_) { const int hh = 2 * hq + h2_; float s_ = 0.f;
#pragma unroll
                    for (int j = 0; j < 4; ++j) { const f32x4 w = *(const LAS f32x4*)(wf + hh * 1024 + lane * 4 + 256 * j); s_ += v[j][0] * w[0] + v[j][1] * w[1] + v[j][2] * w[2] + v[j][3] * w[3]; }
                    d8[hh] = s_; }
                __builtin_amdgcn_sched_barrier(0); }
            float q4[4], q2[2], z;
#pragma unroll
            for (int k = 0; k < 4; ++k) { const float snd = (lane & 32) ? d8[k] : d8[k + 4]; q4[k] = ((lane & 32) ? d8[k + 4] : d8[k]) + shx<32>(snd); }
#pragma unroll
            for (int k = 0; k < 2; ++k) { const float snd = (lane & 16) ? q4[k] : q4[k + 2]; q2[k] = ((lane & 16) ? q4[k + 2] : q4[k]) + shx<16>(snd); }
            { const float snd = (lane & 8) ? q2[0] : q2[1]; z = ((lane & 8) ? q2[1] : q2[0]) + shx<8>(snd); }
            z += shx<4>(z); z += shx<2>(z); z += shx<1>(z);
            if ((lane & 7) == 0) { const int hh = ((lane >> 5) & 1) * 4 + ((lane >> 4) & 1) * 2 + ((lane >> 3) & 1); z += p.b_f[hh]; logf_[(size_t)t * 8 + hh] = -(fmaxf(-z, 0.f) + log1pf(expf(-fabsf(z)))); }
        } }
    }
    __syncthreads();
}
__device__ __forceinline__ void post1_phase(const Params& p) {
    const int tid = otid(), lane = tid & 63, wave = tid >> 6;
    const float* mod = (const float*)(p.ws + WS_MOD); const bf16_t* y = (const bf16_t*)(p.ws + WS_PROJ);
    const int rpb = (T + gridDim.x - 1) / gridDim.x, r0 = blockIdx.x * rpb, r1 = (r0 + rpb < T) ? r0 + rpb : T;
    int cb = -1; f32x4 ga[4], gb[4], sh[4];
    for (int t0 = r0 + wave; t0 < r1; t0 += NWAVE * RW) {
        f32x4 xa[RW][4]; uint2 ya[RW][4];
#pragma unroll
        for (int i = 0; i < RW; ++i) { const int t = t0 + i * NWAVE < r1 ? t0 + i * NWAVE : t0;
#pragma unroll
            for (int j = 0; j < 4; ++j) { ya[i][j] = *(const uint2*)(y + (size_t)t * D + lane * 4 + 256 * j); xa[i][j] = *(const f32x4*)(p.x + (size_t)t * D + lane * 4 + 256 * j); } }
#pragma unroll
        for (int i = 0; i < RW; ++i) { const int t = t0 + i * NWAVE; if (t < r1) {
            const int bb = __builtin_amdgcn_readfirstlane(t / S);
            if (bb != cb) { cb = bb; const float* mb = mod + bb * 6144;
#pragma unroll
                for (int j = 0; j < 4; ++j) { const int col = lane * 4 + 256 * j; ga[j] = *(const f32x4*)(p.g_post_mix + col) * *(const f32x4*)(mb + 2048 + col);
                    gb[j] = *(const f32x4*)(p.g_pre_ffn + col) * (*(const f32x4*)(mb + 4096 + col) + 1.f); sh[j] = *(const f32x4*)(mb + 3072 + col); } }
            f32x4 (&xv)[4] = xa[i]; f32x4 yv[4]; float ss = 0.f;
#pragma unroll
            for (int j = 0; j < 4; ++j) { yv[j] = bf4(ya[i][j]); ss += yv[j][0] * yv[j][0] + yv[j][1] * yv[j][1] + yv[j][2] * yv[j][2] + yv[j][3] * yv[j][3]; }
            ss = wave_sum(ss); const float r = rsqrtf(ss * (1.f / D) + EPS); float s2 = 0.f;
#pragma unroll
            for (int j = 0; j < 4; ++j) { const int col = lane * 4 + 256 * j; xv[j] = xv[j] + yv[j] * r * ga[j]; s2 += xv[j][0] * xv[j][0] + xv[j][1] * xv[j][1] + xv[j][2] * xv[j][2] + xv[j][3] * xv[j][3];
                *(uint2*)((bf16_t*)(p.ws + WS_X1) + (size_t)t * D + col) = make_uint2(pk2(xv[j][0], xv[j][1]), pk2(xv[j][2], xv[j][3])); }
            s2 = wave_sum(s2); const float r2 = rsqrtf(s2 * (1.f / D) + EPS);
            float am = 0.f;
#pragma unroll
            for (int j = 0; j < 4; ++j) { const int col = lane * 4 + 256 * j; const f32x4 o = xv[j] * r2 * gb[j] + sh[j]; xv[j] = o;
                am = fmaxf(am, fmaxf(fmaxf(fabsf(o[0]), fabsf(o[1])), fmaxf(fabsf(o[2]), fabsf(o[3])))); }
            am = wave_max(am);
            const float qs = am > 0.f ? am * (1.f / 127.f) : 1.f, qi = 1.f / qs;
#pragma unroll
            for (int j = 0; j < 4; ++j) { const int col = lane * 4 + 256 * j; const int q0 = __float2int_rn(xv[j][0] * qi), q1 = __float2int_rn(xv[j][1] * qi), q2 = __float2int_rn(xv[j][2] * qi), q3 = __float2int_rn(xv[j][3] * qi);
                *(unsigned*)(p.ws + WS_H8 + (size_t)t * D + col) = (unsigned)(q0 & 255) | ((unsigned)(q1 & 255) << 8) | ((unsigned)(q2 & 255) << 16) | ((unsigned)(q3 & 255) << 24); }
            if (lane == 0) ((float*)(p.ws + WS_SH))[t] = qs;
        } }
    }
}

}


namespace sh {
typedef __bf16 bf16x2 __attribute__((ext_vector_type(2)));
typedef float f32x2 __attribute__((ext_vector_type(2)));
constexpr float USCALE = 64.f;
constexpr size_t SHARD_BYTES = (size_t)16384 * 128;
struct Split { int xs0, xs1, nq, q; };
__device__ __forceinline__ Split split(int tid) { Split s; const int G = gridDim.x, b = blockIdx.x; if (G % 8 == 0) { s.xs0 = b & 7; s.xs1 = s.xs0 + 1; s.nq = (G >> 3) * NWAVE; s.q = (b >> 3) * NWAVE + __builtin_amdgcn_readfirstlane(tid >> 6); } else { s.xs0 = 0; s.xs1 = 8; s.nq = G * NWAVE; s.q = b * NWAVE + __builtin_amdgcn_readfirstlane(tid >> 6); } return s; }

__device__ __forceinline__ void u_phase(const Params& p) {
    const int tid = otid(), lane = tid & 63, g = lane >> 3, c = lane & 7;
    const unsigned char* h8 = p.ws + WS_H8; const bf16_t* ids = (const bf16_t*)(p.ws + WS_IDS); bf16_t* apart = (bf16_t*)(p.ws + WS_PQ);
    const Split sp = split(tid);
    const int j0 = ((lane >> 2) & 1) * 8 + ((lane >> 1) & 1) * 4 + (lane & 1) * 2;
    for (int xs = sp.xs0; xs < sp.xs1; ++xs) {
        const unsigned char* U8 = p.ws + WS_PU + (size_t)xs * SHARD_BYTES + c * 16;
        const unsigned char* hb = h8 + xs * 128 + c * 16;
        v4u uA[16], uB[16], hA[1], hB[1], iA[2], iB[2];
#define U_IDS(I, tk) do { const int tc_ = (tk) < T ? (tk) : T - 1; const v4u* ip_ = (const v4u*)(ids + (size_t)tc_ * 128 + g * 16); I[0] = ip_[0]; I[1] = ip_[1]; } while (0)
#define U_GATHER(U, H, I, tk) do { const int tc_ = (tk) < T ? (tk) : T - 1; H[0] = *(const v4u*)(hb + (size_t)tc_ * D); \
        _Pragma("unroll") for (int j = 0; j < 16; ++j) U[j] = *(const v4u*)(U8 + (size_t)((I[j >> 3][(j >> 1) & 3] >> (16 * (j & 1))) & 0xffffu) * 128); } while (0)
#define U_COMPUTE(U, H, tk) do { { float d[16]; \
        _Pragma("unroll") for (int j = 0; j < 16; ++j) { int s_ = 0; \
            _Pragma("unroll") for (int k = 0; k < 4; ++k) s_ = __builtin_amdgcn_sdot4((int)U[j][k], (int)H[0][k], s_, false); \
            d[j] = (float)s_; } \
        float q8[8], q4[4], q2[2]; \
        _Pragma("unroll") for (int i = 0; i < 8; ++i) { const float snd = (lane & 4) ? d[i] : d[i + 8]; q8[i] = ((lane & 4) ? d[i + 8] : d[i]) + shx<4>(snd); } \
        _Pragma("unroll") for (int i = 0; i < 4; ++i) { const float snd = (lane & 2) ? q8[i] : q8[i + 4]; q4[i] = ((lane & 2) ? q8[i + 4] : q8[i]) + shx<2>(snd); } \
        _Pragma("unroll") for (int i = 0; i < 2; ++i) { const float snd = (lane & 1) ? q4[i] : q4[i + 2]; q2[i] = ((lane & 1) ? q4[i + 2] : q4[i]) + shx<1>(snd); } \
        if ((tk) < T) *(unsigned*)(apart + ((size_t)(tk) * 8 + xs) * 128 + g * 16 + j0) = pk2(q2[0], q2[1]); } } while (0)
        const int nq = sp.nq;
        U_IDS(iA, sp.q); U_IDS(iB, sp.q + nq);
        U_GATHER(uA, hA, iA, sp.q);
        for (int t = sp.q; t < T; t += 2 * nq) {
            U_IDS(iA, t + 2 * nq); U_GATHER(uB, hB, iB, t + nq); U_COMPUTE(uA, hA, t);
            U_IDS(iB, t + 3 * nq); U_GATHER(uA, hA, iA, t + 2 * nq); U_COMPUTE(uB, hB, t + nq);
        }
#undef U_IDS
#undef U_GATHER
#undef U_COMPUTE
    }
}
__device__ __forceinline__ void combine_phase(const Params& p) {
    const bf16_t* apart = (const bf16_t*)(p.ws + WS_PQ); const float* gw = (const float*)(p.ws + WS_G);
    for (int i = blockIdx.x * NTHR + otid(); i < T * 16; i += gridDim.x * NTHR) {
        const int t = i >> 4, e0 = (i & 15) * 8; float a[8];
#pragma unroll
        for (int k = 0; k < 8; ++k) a[k] = 0.f;
        v4u pv[8];
#pragma unroll
        for (int x = 0; x < 8; ++x) pv[x] = *(const v4u*)(apart + ((size_t)t * 8 + x) * 128 + e0);
        const f32x4 g0 = *(const f32x4*)(gw + (size_t)t * 128 + e0), g1 = *(const f32x4*)(gw + (size_t)t * 128 + e0 + 4);
#pragma unroll
        for (int x = 0; x < 8; ++x)
#pragma unroll
            for (int k = 0; k < 4; ++k) { a[2 * k] += __uint_as_float(pv[x][k] << 16); a[2 * k + 1] += __uint_as_float(pv[x][k] & 0xffff0000u); }
        { const v4u idw = *(const v4u*)((const bf16_t*)(p.ws + WS_IDS) + (size_t)t * 128 + e0); const float sht = ((const float*)(p.ws + WS_SH))[t]; const float* su = (const float*)(p.ws + WS_SU);
#pragma unroll
          for (int k = 0; k < 8; ++k) a[k] *= su[(idw[k >> 1] >> (16 * (k & 1))) & 0xffffu] * sht; }
        float w[8];
#pragma unroll
        for (int k = 0; k < 8; ++k) { const float u3 = 0.7978845608028654f * (a[k] + 0.044715f * a[k] * a[k] * a[k]); w[k] = (k < 4 ? g0[k] : g1[k - 4]) * 0.5f * a[k] * (1.f + tanhf(u3)) * (1.f / USCALE); }
        { int h0 = __builtin_amdgcn_cvt_pk_fp8_f32(w[0] * 4096.f, w[1] * 4096.f, 0, false); h0 = __builtin_amdgcn_cvt_pk_fp8_f32(w[2] * 4096.f, w[3] * 4096.f, h0, true);
          int h1 = __builtin_amdgcn_cvt_pk_fp8_f32(w[4] * 4096.f, w[5] * 4096.f, 0, false); h1 = __builtin_amdgcn_cvt_pk_fp8_f32(w[6] * 4096.f, w[7] * 4096.f, h1, true);
          const f32x2 a0 = __builtin_amdgcn_cvt_pk_f32_fp8(h0, false), a1 = __builtin_amdgcn_cvt_pk_f32_fp8(h0, true), a2 = __builtin_amdgcn_cvt_pk_f32_fp8(h1, false), a3 = __builtin_amdgcn_cvt_pk_f32_fp8(h1, true);
          int l0 = __builtin_amdgcn_cvt_pk_fp8_f32(w[0] * 4096.f - a0.x, w[1] * 4096.f - a0.y, 0, false); l0 = __builtin_amdgcn_cvt_pk_fp8_f32(w[2] * 4096.f - a1.x, w[3] * 4096.f - a1.y, l0, true);
          int l1 = __builtin_amdgcn_cvt_pk_fp8_f32(w[4] * 4096.f - a2.x, w[5] * 4096.f - a2.y, 0, false); l1 = __builtin_amdgcn_cvt_pk_fp8_f32(w[6] * 4096.f - a3.x, w[7] * 4096.f - a3.y, l1, true);
          unsigned char* wr_ = p.ws + WS_WB + (size_t)t * 256 + 8 * (e0 & 15) + (e0 >> 4);
#pragma unroll
          for (int k = 0; k < 8; ++k) { wr_[8 * k] = (unsigned char)(((k < 4 ? h0 : h1) >> (8 * (k & 3))) & 255); wr_[128 + 8 * k] = (unsigned char)(((k < 4 ? l0 : l1) >> (8 * (k & 3))) & 255); } }
    }
}
__device__ __forceinline__ void v_phase(const Params& p, LAS unsigned char* lds) {
    typedef int v2i_t __attribute__((ext_vector_type(2)));
    typedef unsigned v2u_t __attribute__((ext_vector_type(2)));
    const int tid = otid(), lane = tid & 63, r = lane >> 3, pc = lane & 7, li = lane & 15, kg = lane >> 4;
    const int wv = __builtin_amdgcn_readfirstlane(tid >> 6);
    const unsigned char* ids8 = p.ws + WS_IDS; const unsigned char* w8 = p.ws + WS_WB; bf16_t* y2 = (bf16_t*)(p.ws + WS_H);
    LAS unsigned char* img = lds + wv * 16384;
    LAS unsigned char* aux = lds + 131072 + wv * 1024;
    const int swz = (4 * kg + (li >> 2)) & 7;
    const int rd0 = (8 * kg + (li >> 1)) * 128 + 8 * (li & 1);
    const Split sp = split(tid);
    for (int xs = sp.xs0; xs < sp.xs1; ++xs) {
        const unsigned char* V8 = p.ws + WS_PV + (size_t)xs * SHARD_BYTES;
        v4u I[2]; v2u_t W[4];
        unsigned ra[8];
#pragma unroll
        for (int db = 0; db < 8; ++db) ra[db] = (unsigned)(size_t)img + rd0 + ((db ^ swz) << 4);
#define V_TC(tk) ((tk) < T ? (tk) : T - 1)
#define V_DMA_IDS(tk, buf) __builtin_amdgcn_global_load_lds((const unsigned*)(ids8 + (size_t)V_TC(tk) * 256 + lane * 4), (LAS unsigned*)(aux + (buf) * 256), 4, 0, 0)
#define V_DMA_W(tk, buf) __builtin_amdgcn_global_load_lds((const unsigned*)(w8 + (size_t)V_TC(tk) * 256 + lane * 4), (LAS unsigned*)(aux + 512 + (buf) * 256), 4, 0, 0)
#define V_RD_IDS(buf) do { I[0] = *(const LAS v4u*)(aux + (buf) * 256 + r * 32); I[1] = *(const LAS v4u*)(aux + (buf) * 256 + r * 32 + 16); } while (0)
#define V_RD_W(buf) do { _Pragma("unroll") for (int eb = 0; eb < 4; ++eb) { W[eb] = *(const LAS v2u_t*)(aux + 512 + (buf) * 256 + 128 * (li & 1) + 32 * eb + 8 * kg); } } while (0)
#define V_DMA(eb) do { _Pragma("unroll") for (int q = 0; q < 4; ++q) { const int j_ = 4 * (eb) + q; const unsigned id_ = (I[j_ >> 3][(j_ >> 1) & 3] >> (16 * (j_ & 1))) & 0xffffu; \
            __builtin_amdgcn_global_load_lds((const unsigned*)(V8 + (size_t)id_ * 128 + ((pc ^ ((4 * q + (lane >> 4)) & 7)) << 4)), (LAS unsigned*)(img + (eb) * 4096 + q * 1024), 16, 0, 0); } } while (0)
#define V_L64(q) ((long)(((unsigned long long)(q).y << 32) | (unsigned long long)(q).x))
#define V_VM(n) asm volatile("s_waitcnt vmcnt(" #n ")" ::: "memory")
#define V_STEP(tk, par) do { \
        V_VM(16); \
        V_RD_IDS((par) ^ 1); V_RD_W(par);                                            \
        asm volatile("s_waitcnt lgkmcnt(0)" ::: "memory"); \
        V_DMA_IDS((tk) + 2 * nq, par); V_DMA_W((tk) + nq, (par) ^ 1); \
        f32x4 acc[8]; \
        _Pragma("unroll") for (int db = 0; db < 8; ++db) acc[db] = (f32x4){0.f, 0.f, 0.f, 0.f}; \
        _Pragma("unroll") for (int eb = 0; eb < 4; ++eb) { long b_[8]; \
            V_VM(14); \
            _Pragma("unroll") for (int db = 0; db < 8; ++db) asm volatile("ds_read_b64_tr_b8 %0, %1 offset:%2" : "=v"(b_[db]) : "v"(ra[db]), "n"(eb * 4096) : "memory"); \
            asm volatile("s_waitcnt lgkmcnt(0)" : "+v"(b_[0]), "+v"(b_[1]), "+v"(b_[2]), "+v"(b_[3]), "+v"(b_[4]), "+v"(b_[5]), "+v"(b_[6]), "+v"(b_[7]) :: "memory"); \
            _Pragma("unroll") for (int db = 0; db < 8; ++db) acc[db] = __builtin_amdgcn_mfma_f32_16x16x32_fp8_fp8(V_L64(W[eb]), b_[db], acc[db], 0, 0, 0); \
            asm volatile("s_waitcnt lgkmcnt(0)" ::: "memory");                       \
            V_DMA(eb); } \
        float o0_ = acc[0][0] + acc[0][1], o1_ = acc[4][0] + acc[4][1];              \
        _Pragma("unroll") for (int q_ = 1; q_ < 4; ++q_) { o0_ = (kg == q_) ? acc[q_][0] + acc[q_][1] : o0_; o1_ = (kg == q_) ? acc[4 + q_][0] + acc[4 + q_][1] : o1_; } \
        { bf16_t* yp_ = y2 + (size_t)V_TC(tk) * D + xs * 128 + li; yp_[16 * kg] = f2bf(o0_ * (1.f / 4096.f)); yp_[16 * (4 + kg)] = f2bf(o1_ * (1.f / 4096.f)); } } while (0)
        const int nq = sp.nq;
        V_DMA_IDS(sp.q, 0); V_DMA_W(sp.q, 0);
        V_VM(0);
        V_RD_IDS(0);
        asm volatile("s_waitcnt lgkmcnt(0)" ::: "memory");
        V_DMA_IDS(sp.q + nq, 1);
        V_DMA(0); V_DMA(1); V_DMA(2); V_DMA(3);
        { unsigned* dmy = (unsigned*)(p.ws + 500 * MiB) + (size_t)(blockIdx.x * NWAVE + wv) * 128 + lane; dmy[0] = 0u; dmy[64] = 0u; }
        for (int t = sp.q; t < T; t += 2 * nq) { V_STEP(t, 0); V_STEP(t + nq, 1); }
        V_VM(0);
#undef V_TC
#undef V_DMA_IDS
#undef V_DMA_W
#undef V_RD_IDS
#undef V_RD_W
#undef V_DMA
#undef V_L64
#undef V_VM
#undef V_STEP
    }
}
__device__ __forceinline__ void final_phase(const Params& p) {
    const int tid = otid(), lane = tid & 63, wave = tid >> 6;
    const float* mod = (const float*)(p.ws + WS_MOD); const bf16_t* x1 = (const bf16_t*)(p.ws + WS_X1); const bf16_t* y2 = (const bf16_t*)(p.ws + WS_H);
    constexpr int RW = 4;
    const int rpb = (T + gridDim.x - 1) / gridDim.x, r0 = blockIdx.x * rpb, r1 = (r0 + rpb < T) ? r0 + rpb : T;
    int cb = -1; f32x4 gc[4];
    for (int t0 = r0 + wave; t0 < r1; t0 += NWAVE * RW) {
        uint2 xa[RW][4], za[RW][4];
#pragma unroll
        for (int i = 0; i < RW; ++i) { const int t = t0 + i * NWAVE < r1 ? t0 + i * NWAVE : t0;
#pragma unroll
            for (int j = 0; j < 4; ++j) { xa[i][j] = *(const uint2*)(x1 + (size_t)t * D + lane * 4 + 256 * j); za[i][j] = *(const uint2*)(y2 + (size_t)t * D + lane * 4 + 256 * j); } }
#pragma unroll
        for (int i = 0; i < RW; ++i) { const int t = t0 + i * NWAVE; if (t < r1) {
            const int bb = __builtin_amdgcn_readfirstlane(t / S);
            if (bb != cb) { cb = bb; const float* mb = mod + bb * 6144;
#pragma unroll
                for (int j = 0; j < 4; ++j) { const int col = lane * 4 + 256 * j; gc[j] = *(const f32x4*)(p.g_post_ffn + col) * *(const f32x4*)(mb + 5120 + col); } }
            f32x4 xv[4], zv[4]; float s2 = 0.f;
#pragma unroll
            for (int j = 0; j < 4; ++j) { const uint2 xw = xa[i][j], zw = za[i][j];
                xv[j] = (f32x4){__uint_as_float(xw.x << 16), __uint_as_float(xw.x & 0xffff0000u), __uint_as_float(xw.y << 16), __uint_as_float(xw.y & 0xffff0000u)};
                zv[j] = (f32x4){__uint_as_float(zw.x << 16), __uint_as_float(zw.x & 0xffff0000u), __uint_as_float(zw.y << 16), __uint_as_float(zw.y & 0xffff0000u)};
                s2 += zv[j][0] * zv[j][0] + zv[j][1] * zv[j][1] + zv[j][2] * zv[j][2] + zv[j][3] * zv[j][3]; }
            s2 = wave_sum(s2); const float r2 = rsqrtf(s2 * (1.f / D) + EPS);
#pragma unroll
            for (int j = 0; j < 4; ++j) { const int col = lane * 4 + 256 * j; *(f32x4*)(p.out + (size_t)t * D + col) = xv[j] + zv[j] * r2 * gc[j]; }
        } }
    }
}
}

#define GAS __attribute__((address_space(1)))
typedef GAS unsigned gu32;
#define RLX_AGENT __ATOMIC_RELAXED, __HIP_MEMORY_SCOPE_AGENT
#define XB_TMO      128
#define XB_XCNT(j)  (256  + 64 * (j))
#define XB_XSUB(j)  (1280 + 64 * (j))
#define XB_XGEN(j)  (2304 + 64 * (j))
#define XB_TOP      3328
#define XB_TOPGEN   3392
#define XCD_BAR_WORDS 3456
#define XB_SPIN_CAP (1u << 18)

__device__ __forceinline__ unsigned xb_ld(unsigned* p)              { return __hip_atomic_load(p, __ATOMIC_RELAXED, __HIP_MEMORY_SCOPE_AGENT); }
__device__ __forceinline__ unsigned xb_add(unsigned* p, unsigned v) { return __hip_atomic_fetch_add(p, v, __ATOMIC_RELAXED, __HIP_MEMORY_SCOPE_AGENT); }
__device__ __forceinline__ unsigned xb_xcc_id() { return (unsigned)__builtin_amdgcn_s_getreg((3 << 11) | 20) & 0xFu; }
#define XB_SPIN(cond, bar) do { unsigned _sp = 0; while (cond) { __builtin_amdgcn_s_sleep(1); \
    if ((++_sp & 255u) == 0u) { if (xb_ld(&(bar)[XB_TMO])) break; if (_sp > XB_SPIN_CAP) { atomicAdd(&(bar)[XB_TMO], 1u); break; } } } } while (0)

struct XcdBarrier {
    unsigned* bar; unsigned x;
    volatile LAS unsigned* st;
};

__device__ __forceinline__ XcdBarrier xcd_barrier_post(unsigned* bar, volatile LAS unsigned* st) {
    XcdBarrier b; b.bar = bar; b.x = xb_xcc_id(); b.st = st;
    if (threadIdx.x == 0) (void)xb_add(&bar[XB_XCNT(b.x)], 1u);
    return b;
}
__device__ __forceinline__ void xcd_barrier_complete(unsigned* bar, unsigned x, unsigned& nloc, unsigned& nx) {
    const unsigned G = gridDim.x * gridDim.y * gridDim.z;
    unsigned sum, cnt, mine, sp = 0u;
    for (;;) {
        sum = 0u; cnt = 0u; mine = 0u;
#pragma unroll
        for (unsigned j = 0; j < 16; ++j) { const unsigned c = xb_ld(&bar[XB_XCNT(j)]); sum += c; cnt += (c > 0u) ? 1u : 0u; mine = (j == x) ? c : mine; }
        if (sum == G) break;
        __builtin_amdgcn_s_sleep(1);
        if ((++sp & 255u) == 0u) { if (xb_ld(&bar[XB_TMO])) break; if (sp > XB_SPIN_CAP) { atomicAdd(&bar[XB_TMO], 1u); break; } }
    }
    nloc = mine > 0u ? mine : 1u; nx = cnt > 0u ? cnt : 1u;
}

__device__ __forceinline__ void xcd_barrier(const XcdBarrier& b) {
    asm volatile("s_waitcnt vmcnt(0)" ::: "memory");
    __syncthreads();
    if (threadIdx.x == 0) {
        unsigned* bar = b.bar;
        __builtin_amdgcn_s_waitcnt(0);
        unsigned nloc = b.st[0], nx = b.st[1];
        if (nloc == 0u) { xcd_barrier_complete(bar, b.x, nloc, nx); b.st[0] = nloc; b.st[1] = nx; }
        const unsigned old = xb_add(&bar[XB_XSUB(b.x)], 1u);
        const unsigned gen = old / nloc;
        if (old + 1u == (gen + 1u) * nloc) {
            __builtin_amdgcn_fence(__ATOMIC_RELEASE, "agent");
            asm volatile("s_waitcnt vmcnt(0)" ::: "memory");
            const unsigned og = xb_add(&bar[XB_TOP], 1u);
            const unsigned tg = og / nx;
            if (og + 1u == (tg + 1u) * nx) xb_add(&bar[XB_TOPGEN], 1u);
            else XB_SPIN(xb_ld(&bar[XB_TOPGEN]) == tg, bar);
            __builtin_amdgcn_fence(__ATOMIC_ACQUIRE, "agent");
            xb_add(&bar[XB_XGEN(b.x)], 1u);
            asm volatile("s_waitcnt vmcnt(0)" ::: "memory");
        } else {
            XB_SPIN(xb_ld(&bar[XB_XGEN(b.x)]) == gen, bar);
            __builtin_amdgcn_fence(__ATOMIC_ACQUIRE, "agent");
            asm volatile("s_waitcnt vmcnt(0)" ::: "memory");
        }
    }
    __syncthreads();
}


constexpr int MISC_OFF = LDS_BYTES - 256;
constexpr int CW_BAR = 1024;
constexpr size_t CTL_ZERO_BYTES = 32768;
static_assert((CW_BAR + XCD_BAR_WORDS) * 4 <= (int)CTL_ZERO_BYTES, "control region");
static_assert(att::L_END <= MISC_OFF && pg8::STAGE_BYTES <= MISC_OFF, "LDS map");

__device__ __forceinline__ void gemm_dispatch(const Params& p, LAS unsigned char* lds, int which) {
    unsigned char* ws = p.ws;
    if (which == 0) {
        pg8::Gemm g{(const bf16_t*)(ws + WS_H), (const bf16_t*)(ws + WS_WINT), T, NP, D / 2}; pg8::StaticOrder S_; S_.init(T, NP, gridDim.x, blockIdx.x);
        pg8::EpiI8S E{(bf16_t*)(ws + WS_PROJ), NP, (const float*)(ws + WS_S1), (const float*)(ws + WS_CS)};
        pg8::gemm_phase<pg8::EpiI8S, pg8::StaticOrder, true, true, true>(lds, g, S_, E);
    } else if (which == 1) {
        pg8::Gemm g{(const bf16_t*)(ws + WS_OCAT), (const bf16_t*)(ws + WS_WOT), T, D, D}; pg8::StaticOrder S_; S_.init(T, D, gridDim.x, blockIdx.x);
        pg8::EpiBf16S E{(bf16_t*)(ws + WS_PROJ), D, 0u, 1.f};
        pg8::gemm_phase<pg8::EpiBf16S, pg8::StaticOrder, true, true>(lds, g, S_, E);
    } else {
        pg8::Gemm g{(const bf16_t*)(ws + WS_H8), (const bf16_t*)(ws + WS_WPQT), T, 2048, D / 2}; pg8::StaticOrder S_; S_.init(T, 2048, gridDim.x, blockIdx.x);
        pg8::EpiI8S E{(bf16_t*)(ws + WS_PQ), 2048, (const float*)(ws + WS_SH), (const float*)(ws + WS_CS) + 3072};
        pg8::gemm_phase<pg8::EpiI8S, pg8::StaticOrder, true, true, true>(lds, g, S_, E);
    }
}

__global__ __launch_bounds__(NTHR, 2) void k_mega(Params p) {
    extern __shared__ __attribute__((aligned(16))) unsigned char lds_raw[];
    LAS unsigned char* lds = (LAS unsigned char*)lds_raw;
    volatile LAS unsigned* MISC = (volatile LAS unsigned*)(lds + MISC_OFF);
    if (threadIdx.x < 64) MISC[threadIdx.x] = 0u;
    __syncthreads();
    XcdBarrier bar = xcd_barrier_post((unsigned*)(p.ws + WS_CTL) + CW_BAR, MISC + 8);
    phase0(p, lds);                  xcd_barrier(bar);
    rw::norm1_phase(p, lds);         xcd_barrier(bar);
    gemm_dispatch(p, lds, 0);        xcd_barrier(bar);
    att::attn_phase(p, lds);         xcd_barrier(bar);
    gemm_dispatch(p, lds, 1);        xcd_barrier(bar);
    rw::post1_phase(p);              xcd_barrier(bar);
    gemm_dispatch(p, lds, 2);        xcd_barrier(bar);
    tk::topk_phase(p, lds);          xcd_barrier(bar);
    sh::u_phase(p);                  xcd_barrier(bar);
    sh::combine_phase(p);            xcd_barrier(bar);
    sh::v_phase(p, lds);             xcd_barrier(bar);
    sh::final_phase(p);
}

extern "C" void kernel_launch(void* const* d_in, const int* in_sizes, int n_in, void* d_out, int out_size, void* d_ws, size_t ws_size, hipStream_t stream) {
    Params p{};
    const float** pp = (const float**)&p;
    for (int i = 0; i < 21; ++i) pp[i] = (const float*)d_in[i];
    p.out = (float*)d_out; p.ws = (unsigned char*)d_ws;
    static int grid = 0;
    if (!grid) {
        (void)hipFuncSetAttribute((const void*)k_mega, hipFuncAttributeMaxDynamicSharedMemorySize, LDS_BYTES);
        int dev = 0, cus = 0, per_cu = 0; (void)hipGetDevice(&dev); (void)hipDeviceGetAttribute(&cus, hipDeviceAttributeMultiprocessorCount, dev);
        (void)hipOccupancyMaxActiveBlocksPerMultiprocessor(&per_cu, (const void*)k_mega, NTHR, LDS_BYTES);
        if (cus <= 0) cus = 256; if (per_cu < 1) per_cu = 1;
        grid = cus * 1;
    }
    (void)hipMemsetAsync((char*)d_ws + WS_CTL, 0, CTL_ZERO_BYTES, stream);
    void* args[] = {(void*)&p};
    (void)hipLaunchCooperativeKernel((const void*)k_mega, dim3(grid), dim3(NTHR), args, LDS_BYTES, stream);
}
```

```cpp
#include <hip/hip_runtime.h>
#include <stdint.h>
#include <math.h>

typedef unsigned short bf16_t;
constexpr int NB = 8, S = 4096, D = 1024, T = NB * S;
constexpr int NPROJ = 3080, NP = 3072;
constexpr float EPS = 1e-6f;
constexpr size_t MiB = 1u << 20;
constexpr size_t WS_CTL = 0;
constexpr size_t WS_SU = 256 * 1024;
constexpr size_t WS_SH = 384 * 1024;
constexpr size_t WS_MOD = 1 * MiB;
constexpr size_t WS_WF = 1 * MiB + 256 * 1024;
constexpr size_t WS_SKB = 1 * MiB + 512 * 1024;
constexpr size_t WS_LOGF = 2 * MiB;
constexpr size_t WS_CS = 3 * MiB;
constexpr size_t WS_S1 = 3 * MiB + 65536;
constexpr size_t WS_WINT = 4 * MiB;
constexpr size_t WS_WOT = 10 * MiB;
constexpr size_t WS_WPQT = 12 * MiB;
constexpr size_t WS_PU = 16 * MiB;
constexpr size_t WS_PV = 48 * MiB;
constexpr size_t WS_H = 80 * MiB;
constexpr size_t WS_PROJ = 144 * MiB;
constexpr size_t WS_X1 = 208 * MiB;
constexpr size_t WS_PQ = 272 * MiB;
constexpr size_t WS_OCAT = 400 * MiB;
constexpr size_t WS_H8 = 400 * MiB;
constexpr size_t WS_IDS = 464 * MiB;
constexpr size_t WS_WB = 472 * MiB;
constexpr size_t WS_G = 480 * MiB;

__device__ __forceinline__ float bf2f(bf16_t v) { return __uint_as_float(((unsigned)v) << 16); }
__device__ __forceinline__ bf16_t f2bf(float f) { unsigned u = __float_as_uint(f); return (bf16_t)((u + 0x7fffu + ((u >> 16) & 1u)) >> 16); }
template <int CTRL> __device__ __forceinline__ float dppf(float x) { return __builtin_bit_cast(float, __builtin_amdgcn_mov_dpp(__builtin_bit_cast(int, x), CTRL, 0xf, 0xf, true)); }
__device__ __forceinline__ unsigned lane_id() { return __builtin_amdgcn_mbcnt_hi(~0u, __builtin_amdgcn_mbcnt_lo(~0u, 0u)); }
template <int O> __device__ __forceinline__ float shx(float v) {
    if constexpr (O == 1) return dppf<0xB1>(v);
    else if constexpr (O == 2) return dppf<0x4E>(v);
    else if constexpr (O == 4) return dppf<0x141>(dppf<0x1B>(v));
    else if constexpr (O == 8) return dppf<0x128>(v);
    else if constexpr (O == 16) { auto rr = __builtin_amdgcn_permlane16_swap(__float_as_uint(v), __float_as_uint(v), false, false); return __uint_as_float((lane_id() & 16u) ? rr[0] : rr[1]); }
    else { auto rr = __builtin_amdgcn_permlane32_swap(__float_as_uint(v), __float_as_uint(v), false, false); return __uint_as_float((lane_id() & 32u) ? rr[0] : rr[1]); }
}
#define XL_RED(NAME, OP) \
__device__ __forceinline__ float row16_##NAME(float v) { v = OP(v, dppf<0xB1>(v)); v = OP(v, dppf<0x4E>(v)); v = OP(v, dppf<0x141>(v)); v = OP(v, dppf<0x128>(v)); return v; }     \
__device__ __forceinline__ float half_##NAME(float v) { v = row16_##NAME(v); auto s = __builtin_amdgcn_permlane16_swap(__float_as_uint(v), __float_as_uint(v), false, false); return OP(__uint_as_float(s[0]), __uint_as_float(s[1])); }     \
__device__ __forceinline__ float wave_##NAME(float v) { v = half_##NAME(v); auto t = __builtin_amdgcn_permlane32_swap(__float_as_uint(v), __float_as_uint(v), false, false); return OP(__uint_as_float(t[0]), __uint_as_float(t[1])); }
__device__ __forceinline__ float xl_add(float a, float b) { return a + b; }
XL_RED(sum, xl_add)
XL_RED(max, fmaxf)
XL_RED(min, fminf)
#undef XL_RED

__device__ __forceinline__ int t5_bucket(int dist) {
    if (dist < 16) return dist;
    float nf = (float)(dist < 1 ? 1 : dist);
    int large = 16 + (int)(logf(nf / 16.f) / logf(128.f / 16.f) * 16.f);
    return large < 31 ? large : 31;
}

namespace pg8 {
#define PG8_LAS __attribute__((address_space(3)))
typedef unsigned short bf16_t;
typedef short bf16x8 __attribute__((ext_vector_type(8)));
typedef float f32x4 __attribute__((ext_vector_type(4)));
typedef unsigned u32x4 __attribute__((ext_vector_type(4)));
typedef int i32x4 __attribute__((ext_vector_type(4)));
template <bool I8> struct AccT { typedef f32x4 type; };
template <> struct AccT<true> { typedef i32x4 type; };
constexpr int BM = 256, BK = 64, HALF = 128, HTB = HALF * BK * 2  , STAGE_BYTES = 8 * HTB, NXCD = 8, WGM = 8;

__host__ __device__ __forceinline__ int lds_byte(int r, int c) { const int st = (r >> 4) * 2 + (c >> 5), rr = r & 15, cc = c & 31, ob = rr * 64 + cc * 2; return st * 1024 + (ob ^ (((ob >> 9) & 1) << 5)); }
__host__ __device__ __forceinline__ void stage_rc(int b, int& R, int& C) { const int st = b / 1024, sb = b % 1024, swz = sb ^ (((sb >> 9) & 1) << 5); R = (st >> 1) * 16 + swz / 64; C = (st & 1) * 32 + (swz % 64) / 2; }
__host__ __device__ __forceinline__ int perm32(int rho) { const int n = rho >> 4, i = rho & 15; return 8 * (i >> 2) + 4 * n + (i & 3); }

struct Unit { int pm, pn; };
struct Gemm { const bf16_t* A; const bf16_t* Bt; int M, N, K; };

struct StaticOrder {
    int nM, nN, nwg, G, c;
    __host__ __device__ void init(int M, int N, int G_, int c_) { nM = M / BM; nN = N / BM; nwg = nM * nN; G = G_; c = c_; }
    __host__ __device__ bool next(int i, Unit& u) const {
        const long L = (long)i * G + c; if (L >= nwg) return false;
        int wgid = (int)L; { const int q = nwg / NXCD, r = nwg % NXCD, xcd = wgid % NXCD, off = wgid / NXCD; wgid = (xcd < r ? xcd * (q + 1) : r * (q + 1) + (xcd - r) * q) + off; }
        const int nig = WGM * nN, gid = wgid / nig, fm = gid * WGM, gsz = (nM - fm) < WGM ? (nM - fm) : WGM;
        u.pm = fm + ((wgid % nig) % gsz); u.pn = (wgid % nig) / gsz; return true;
    }
    __device__ __forceinline__ void a_ready(const Unit&) const {}
    __device__ __forceinline__ void done(const Unit&) const {}
};

__device__ __forceinline__ unsigned cvt_pk_bf16(float lo, float hi) { unsigned r; asm volatile("v_cvt_pk_bf16_f32 %0, %1, %2" : "=v"(r) : "v"(lo), "v"(hi)); return r; }
struct EpiBf16S {
    static constexpr bool PERM = true, AFTER_DRAIN = false;
    bf16_t* O; int ldc; unsigned scale_mask; float scale;
    __device__ __forceinline__ void operator()(const f32x4 (&acc)[2][2][4][2], const Unit& u, int wr, int wc, int fr, int fq) const {
        const int row0 = u.pm * BM + wr * 64 + fr; const int col0 = u.pn * BM + wc * 32 + 8 * fq;
        const float sc = ((scale_mask >> u.pn) & 1u) ? scale : 1.f;
#pragma unroll
        for (int ai = 0; ai < 2; ++ai)
#pragma unroll
            for (int m = 0; m < 4; ++m) { bf16_t* rowp = O + (size_t)(row0 + ai * HALF + m * 16) * ldc + col0;
#pragma unroll
                for (int bj = 0; bj < 2; ++bj) { f32x4 v0 = acc[ai][bj][m][0] * sc, v1 = acc[ai][bj][m][1] * sc;
                    u32x4 w; w.x = cvt_pk_bf16(v0[0], v0[1]); w.y = cvt_pk_bf16(v0[2], v0[3]); w.z = cvt_pk_bf16(v1[0], v1[1]); w.w = cvt_pk_bf16(v1[2], v1[3]);
                    *(u32x4*)(rowp + bj * HALF) = w; } }
    }
};
struct EpiI8S {
    static constexpr bool PERM = true, AFTER_DRAIN = false;
    bf16_t* O; int ldc; const float* rs; const float* cs;
    __device__ __forceinline__ void operator()(const i32x4 (&acc)[2][2][4][2], const Unit& u, int wr, int wc, int fr, int fq) const {
        const int row0 = u.pm * BM + wr * 64 + fr; const int col0 = u.pn * BM + wc * 32 + 8 * fq;
        f32x4 c0[2], c1[2];
#pragma unroll
        for (int bj = 0; bj < 2; ++bj) { c0[bj] = *(const f32x4*)(cs + col0 + bj * HALF); c1[bj] = *(const f32x4*)(cs + col0 + bj * HALF + 4); }
#pragma unroll
        for (int ai = 0; ai < 2; ++ai)
#pragma unroll
            for (int m = 0; m < 4; ++m) { const int r = row0 + ai * HALF + m * 16; bf16_t* rowp = O + (size_t)r * ldc + col0; const float sr = rs[r];
#pragma unroll
                for (int bj = 0; bj < 2; ++bj) { const f32x4 v0 = __builtin_convertvector(acc[ai][bj][m][0], f32x4) * sr * c0[bj], v1 = __builtin_convertvector(acc[ai][bj][m][1], f32x4) * sr * c1[bj];
                    u32x4 w; w.x = cvt_pk_bf16(v0[0], v0[1]); w.y = cvt_pk_bf16(v0[2], v0[3]); w.z = cvt_pk_bf16(v1[0], v1[1]); w.w = cvt_pk_bf16(v1[2], v1[3]);
                    *(u32x4*)(rowp + bj * HALF) = w; } }
    }
};
struct EpiF32 {
    static constexpr bool PERM = false, AFTER_DRAIN = false;
    float* O; int ldc;
    __device__ __forceinline__ void operator()(const f32x4 (&acc)[2][2][4][2], const Unit& u, int wr, int wc, int fr, int fq) const {
        const int col0 = u.pn * BM + wc * 32 + 4 * fq;
#pragma unroll
        for (int ai = 0; ai < 2; ++ai)
#pragma unroll
            for (int m = 0; m < 4; ++m) { float* rowp = O + (size_t)(u.pm * BM + ai * HALF + wr * 64 + m * 16 + fr) * ldc + col0;
#pragma unroll
                for (int bj = 0; bj < 2; ++bj)
#pragma unroll
                    for (int n = 0; n < 2; ++n) *(f32x4*)(rowp + bj * HALF + n * 16) = acc[ai][bj][m][n]; }
    }
};

template <class Epi, class Sched, bool ALIGN_EPI = false, bool SP2 = false, bool I8 = false>
__device__ __forceinline__ void gemm_phase(PG8_LAS unsigned char* lds, const Gemm g, const Sched& S, const Epi& E) {
    int tid_ = threadIdx.x; asm volatile("" : "+v"(tid_));
    const int tid = tid_, wid = __builtin_amdgcn_readfirstlane(tid >> 6), lane = tid & 63, wr = wid >> 2, wc = wid & 3, fr = lane & 15, fq = lane >> 4;
    const int K = g.K, nt = K / BK;
    unsigned voffA[2], voffB[2];
#pragma unroll
    for (int i = 0; i < 2; ++i) { int R, C; stage_rc(tid * 16 + i * 8192, R, C); const int Rb = Epi::PERM ? ((R & ~31) + perm32(R & 31)) : R;
        voffA[i] = (unsigned)(R * K + C) * 2u; voffB[i] = (unsigned)(Rb * K + C) * 2u; }
    const size_t kstep = (size_t)(BK * 2);
    const size_t hstep = (size_t)HALF * K * 2;
    const size_t tstep = 2 * hstep;
    const unsigned ldsw = (unsigned)wid * 1024u;
    const int aoff = lds_byte(wr * 64 + fr, fq * 8), boff = lds_byte(wc * 32 + fr, fq * 8);
#define PG8_SA(b, h) (((b) * 2 + (h)) * HTB)
#define PG8_SB(b, h) ((4 + (b) * 2 + (h)) * HTB)
#define PG8_STAGE(bufoff, gbase, voff) do { _Pragma("unroll") for (int _i = 0; _i < 2; ++_i) \
        __builtin_amdgcn_global_load_lds((const unsigned*)((const char*)(gbase) + (voff)[_i]), (PG8_LAS unsigned*)(lds + (bufoff) + ldsw + _i * 8192), 16, 0, 0); } while (0)
#define PG8_LDA(dst, b, h) do { _Pragma("unroll") for (int m = 0; m < 4; ++m) _Pragma("unroll") for (int k = 0; k < 2; ++k) dst[m][k] = *(const PG8_LAS bf16x8*)(lds + PG8_SA(b, h) + aoff + m * 2048 + k * 1024); } while (0)
#define PG8_LDB(dst, b, h) do { _Pragma("unroll") for (int n = 0; n < 2; ++n) _Pragma("unroll") for (int k = 0; k < 2; ++k) dst[n][k] = *(const PG8_LAS bf16x8*)(lds + PG8_SB(b, h) + boff + n * 2048 + k * 1024); } while (0)
#define PG8_MMA(ai, bj, At, Bt) do { __builtin_amdgcn_s_setprio(1); _Pragma("unroll") for (int m = 0; m < 4; ++m) _Pragma("unroll") for (int n = 0; n < 2; ++n) _Pragma("unroll") for (int k = 0; k < 2; ++k) \
        { if constexpr (I8) acc[ai][bj][m][n] = __builtin_amdgcn_mfma_i32_16x16x64_i8(__builtin_bit_cast(i32x4, Bt[n][k]), __builtin_bit_cast(i32x4, At[m][k]), acc[ai][bj][m][n], 0, 0, 0); \
          else acc[ai][bj][m][n] = __builtin_amdgcn_mfma_f32_16x16x32_bf16(Bt[n][k], At[m][k], acc[ai][bj][m][n], 0, 0, 0); } __builtin_amdgcn_s_setprio(0); } while (0)
#define PG8_WAIT_V(n) asm volatile("s_waitcnt vmcnt(" #n ")" ::: "memory")
#define PG8_WAIT_L(n) asm volatile("s_waitcnt lgkmcnt(" #n ")" ::: "memory")
#define PG8_BAR __builtin_amdgcn_s_barrier()
#define PG8_SCHED __builtin_amdgcn_sched_barrier(0)
    Unit cur, nxt; int ui = 0;
    if (!S.next(0, cur)) return;
    typedef typename AccT<I8>::type acc_t;
    acc_t acc[2][2][4][2];
#pragma unroll
    for (int a = 0; a < 2; ++a)
#pragma unroll
        for (int b = 0; b < 2; ++b)
#pragma unroll
            for (int m = 0; m < 4; ++m)
#pragma unroll
                for (int n = 0; n < 2; ++n) acc[a][b][m][n] = (acc_t){0, 0, 0, 0};
    bf16x8 At[4][2], B0[2][2], B1[2][2];
    const char* cA = (const char*)g.A + (size_t)cur.pm * tstep; const char* cB = (const char*)g.Bt + (size_t)cur.pn * tstep;
    S.a_ready(cur);
    if constexpr (SP2) {
        PG8_STAGE(PG8_SB(0, 0), cB, voffB); PG8_STAGE(PG8_SB(0, 1), cB + hstep, voffB); PG8_STAGE(PG8_SA(0, 0), cA, voffA); PG8_STAGE(PG8_SA(0, 1), cA + hstep, voffA);
        if (wr == 1) PG8_BAR;
        PG8_WAIT_V(2); PG8_BAR;
        PG8_STAGE(PG8_SB(1, 0), cB + kstep, voffB); PG8_STAGE(PG8_SA(1, 0), cA + kstep, voffA); PG8_STAGE(PG8_SB(1, 1), cB + hstep + kstep, voffB);
        PG8_WAIT_V(6); PG8_BAR;
    } else {
        PG8_STAGE(PG8_SB(0, 0), cB, voffB); PG8_STAGE(PG8_SA(0, 0), cA, voffA); PG8_STAGE(PG8_SB(0, 1), cB + hstep, voffB); PG8_STAGE(PG8_SA(0, 1), cA + hstep, voffA);
        if (wr == 1) PG8_BAR;
        PG8_WAIT_V(4); PG8_BAR;
        PG8_STAGE(PG8_SB(1, 0), cB + kstep, voffB); PG8_STAGE(PG8_SA(1, 0), cA + kstep, voffA); PG8_STAGE(PG8_SB(1, 1), cB + hstep + kstep, voffB);
        PG8_WAIT_V(6); PG8_BAR;
    }
    for (;;) {
        const bool has_next = S.next(ui + 1, nxt);
        const char* nA = has_next ? (const char*)g.A + (size_t)nxt.pm * tstep : cA; const char* nB = has_next ? (const char*)g.Bt + (size_t)nxt.pn * tstep : cB;
        for (int t = 0; t < nt; t += 2) {
            const bool last = (t == nt - 2);
            const char* a1 = cA + (size_t)(t + 1) * kstep;
            const char* a2 = last ? nA : cA + (size_t)(t + 2) * kstep; const char* b2 = last ? nB : cB + (size_t)(t + 2) * kstep;
            const char* a3 = a2 + kstep; const char* b3 = b2 + kstep;
            if (last && has_next) S.a_ready(nxt);
            if constexpr (SP2) {
            PG8_LDB(B0, 0, 0); PG8_LDB(B1, 0, 1); PG8_SCHED; PG8_LDA(At, 0, 0); PG8_STAGE(PG8_SA(1, 1), a1 + hstep, voffA);
            PG8_WAIT_V(8); PG8_WAIT_L(0); PG8_BAR; PG8_MMA(0, 0, At, B0); PG8_MMA(0, 1, At, B1); PG8_BAR; PG8_SCHED;
            PG8_LDA(At, 0, 1); PG8_STAGE(PG8_SB(0, 0), b2, voffB); PG8_STAGE(PG8_SB(0, 1), b2 + hstep, voffB); PG8_STAGE(PG8_SA(0, 0), a2, voffA);
            PG8_WAIT_V(8); PG8_WAIT_L(0); PG8_BAR; PG8_MMA(1, 0, At, B0); PG8_MMA(1, 1, At, B1); PG8_BAR; PG8_SCHED;
            PG8_LDB(B0, 1, 0); PG8_LDB(B1, 1, 1); PG8_SCHED; PG8_LDA(At, 1, 0); PG8_STAGE(PG8_SA(0, 1), a2 + hstep, voffA);
            PG8_WAIT_V(8); PG8_WAIT_L(0); PG8_BAR; PG8_MMA(0, 0, At, B0); PG8_MMA(0, 1, At, B1); PG8_BAR; PG8_SCHED;
            PG8_LDA(At, 1, 1); PG8_STAGE(PG8_SB(1, 0), b3, voffB); PG8_STAGE(PG8_SB(1, 1), b3 + hstep, voffB); PG8_STAGE(PG8_SA(1, 0), a3, voffA);
            PG8_WAIT_V(8); PG8_WAIT_L(0); PG8_BAR; PG8_MMA(1, 0, At, B0); PG8_MMA(1, 1, At, B1); PG8_BAR; PG8_SCHED;
            } else {
            PG8_LDB(B0, 0, 0); PG8_SCHED; PG8_LDA(At, 0, 0); PG8_STAGE(PG8_SA(1, 1), a1 + hstep, voffA);
            PG8_WAIT_L(8); PG8_BAR; PG8_WAIT_L(0); PG8_MMA(0, 0, At, B0); PG8_BAR; PG8_SCHED;
            PG8_LDB(B1, 0, 1); PG8_STAGE(PG8_SB(0, 0), b2, voffB);
            PG8_BAR; PG8_WAIT_L(0); PG8_MMA(0, 1, At, B1); PG8_BAR;
            PG8_LDA(At, 0, 1); PG8_STAGE(PG8_SA(0, 0), a2, voffA);
            PG8_BAR; PG8_WAIT_L(0); PG8_MMA(1, 0, At, B0); PG8_BAR; PG8_SCHED;
            PG8_STAGE(PG8_SB(0, 1), b2 + hstep, voffB);
            PG8_WAIT_V(6); PG8_BAR; PG8_MMA(1, 1, At, B1); PG8_BAR;
            PG8_LDB(B0, 1, 0); PG8_SCHED; PG8_LDA(At, 1, 0); PG8_STAGE(PG8_SA(0, 1), a2 + hstep, voffA);
            PG8_WAIT_L(8); PG8_BAR; PG8_WAIT_L(0); PG8_MMA(0, 0, At, B0); PG8_BAR; PG8_SCHED;
            PG8_LDB(B1, 1, 1); PG8_STAGE(PG8_SB(1, 0), b3, voffB);
            PG8_BAR; PG8_WAIT_L(0); PG8_MMA(0, 1, At, B1); PG8_BAR;
            PG8_LDA(At, 1, 1); PG8_STAGE(PG8_SA(1, 0), a3, voffA);
            PG8_BAR; PG8_WAIT_L(0); PG8_MMA(1, 0, At, B0); PG8_BAR; PG8_SCHED;
            PG8_STAGE(PG8_SB(1, 1), b3 + hstep, voffB);
            PG8_WAIT_V(6); PG8_BAR; PG8_MMA(1, 1, At, B1); PG8_BAR;
            }
        }
        if constexpr (ALIGN_EPI) { if (wr == 0) PG8_BAR; }
        if constexpr (!Epi::AFTER_DRAIN) { E(acc, cur, wr, wc, fr, fq); S.done(cur); }
        if (!has_next) break;
#pragma unroll
        for (int a = 0; a < 2; ++a)
#pragma unroll
            for (int b = 0; b < 2; ++b)
#pragma unroll
                for (int m = 0; m < 4; ++m)
#pragma unroll
                    for (int n = 0; n < 2; ++n) acc[a][b][m][n] = (acc_t){0, 0, 0, 0};
        cur = nxt; cA = nA; cB = nB; ++ui;
        if constexpr (ALIGN_EPI) { if (wr == 1) PG8_BAR; }
    }
    PG8_WAIT_V(0);
    if constexpr (!ALIGN_EPI) { if (wr == 0) PG8_BAR; }
    PG8_BAR;
    if constexpr (Epi::AFTER_DRAIN) { E.fused(acc, cur, wr, wc, fr, fq, lds, wid, lane); S.done(cur); }
#undef PG8_SA
#undef PG8_SB
#undef PG8_STAGE
#undef PG8_LDA
#undef PG8_LDB
#undef PG8_MMA
#undef PG8_WAIT_V
#undef PG8_WAIT_L
#undef PG8_BAR
#undef PG8_SCHED
}
}

#define LAS __attribute__((address_space(3)))
typedef float f32x4 __attribute__((ext_vector_type(4)));
typedef unsigned v4u __attribute__((ext_vector_type(4)));
constexpr int NTHR = 512, NWAVE = 8;
constexpr int LDS_BYTES = 147456;
constexpr float C2 = 0.125f * 1.4426950408889634f;

struct Params {
    const float *x, *c, *rel_bias, *w_ada, *b_ada, *g_pre_mix, *g_post_mix, *w_in, *b_f, *lq1, *lk1, *lq2, *lk2, *g_subln, *w_o, *g_pre_ffn, *g_post_ffn, *w_pq, *sub_keys, *peer_u, *peer_v;
    float* out; unsigned char* ws;
};
__device__ __forceinline__ int otid() { int t = threadIdx.x; asm volatile("" : "+v"(t)); return t; }
__device__ __forceinline__ unsigned pk2(float lo, float hi) { return (unsigned)f2bf(lo) | ((unsigned)f2bf(hi) << 16); }

__device__ __forceinline__ void p0_transpose_item(const float* W, int K, int N, int ldw, bf16_t* WT, LAS float* scr, int item, int lane) {
    const int nblk = N / 32, kb = item / nblk, nb = item % nblk, k0 = 64 * kb, n0 = 32 * nb;
#pragma unroll 8
    for (int i = 0; i < 32; ++i) { const int kk = 2 * i + (lane >> 5); scr[kk * 33 + (lane & 31)] = W[(size_t)(k0 + kk) * ldw + n0 + (lane & 31)]; }
    asm volatile("s_waitcnt lgkmcnt(0)" ::: "memory");
    const int c = lane & 7;
#pragma unroll
    for (int j = 0; j < 4; ++j) { const int n = (lane >> 3) + 8 * j; const LAS float* s = scr + (8 * c) * 33 + n;
        v4u o; o.x = pk2(s[0 * 33], s[1 * 33]); o.y = pk2(s[2 * 33], s[3 * 33]); o.z = pk2(s[4 * 33], s[5 * 33]); o.w = pk2(s[6 * 33], s[7 * 33]);
        *(v4u*)(WT + (size_t)(n0 + n) * K + k0 + 8 * c) = o; }
    asm volatile("s_waitcnt lgkmcnt(0)" ::: "memory");
}

__device__ __forceinline__ void p0_quant_panel(const float* W, int ldw, int n0, unsigned char* WT8, float* csout, float csmul, LAS unsigned char* lds, int tid) {
    const int lane = tid & 63, wave = tid >> 6;
    LAS float* scr = (LAS float*)(lds + wave * 17408);
    LAS float* red = (LAS float*)(lds + 8 * 17408);
#pragma unroll 8
    for (int i = 0; i < 64; ++i) { const int kk = 2 * i + (lane >> 5); scr[kk * 33 + (lane & 31)] = W[(size_t)(128 * wave + kk) * ldw + n0 + (lane & 31)]; }
    asm volatile("s_waitcnt lgkmcnt(0)" ::: "memory");
    { const int n = lane & 31, half = lane >> 5; float m = 0.f;
#pragma unroll 8
      for (int i = 0; i < 64; ++i) m = fmaxf(m, fabsf(scr[(64 * half + i) * 33 + n]));
      red[(2 * wave + half) * 32 + n] = m; }
    __syncthreads();
    const int c = lane & 7;
#pragma unroll
    for (int j = 0; j < 4; ++j) { const int n = (lane >> 3) + 8 * j; float mx = 0.f;
#pragma unroll
        for (int q = 0; q < 16; ++q) mx = fmaxf(mx, red[q * 32 + n]);
        const float sc = mx > 0.f ? mx * (1.f / 127.f) : 1.f, inv = 1.f / sc;
        if (wave == 0 && c == 0) csout[n0 + n] = sc * csmul;
        const LAS float* s_ = scr + (16 * c) * 33 + n; v4u o;
#pragma unroll
        for (int k = 0; k < 4; ++k) { const int q0 = __float2int_rn(s_[(4 * k) * 33] * inv), q1 = __float2int_rn(s_[(4 * k + 1) * 33] * inv), q2 = __float2int_rn(s_[(4 * k + 2) * 33] * inv), q3 = __float2int_rn(s_[(4 * k + 3) * 33] * inv);
            o[k] = (unsigned)(q0 & 255) | ((unsigned)(q1 & 255) << 8) | ((unsigned)(q2 & 255) << 16) | ((unsigned)(q3 & 255) << 24); }
        *(v4u*)(WT8 + (size_t)(n0 + n) * 1024 + 128 * wave + 16 * c) = o; }
    __syncthreads();
}

__device__ __forceinline__ void phase0(const Params& p, LAS unsigned char* lds) {
    const int tid = otid(), lane = tid & 63, wave = tid >> 6, G = gridDim.x, bid = blockIdx.x;
    unsigned char* ws = p.ws;
    if (bid < 96) {
        LAS float* sl = (LAS float*)lds;
        LAS float* red = (LAS float*)(lds + 32768);
        for (int i = tid; i < 8192; i += NTHR) { float v = p.c[i]; sl[i] = v / (1.f + expf(-v)); }
        __syncthreads();
      for (int ch = bid; ch < 96; ch += G) {
        const int col = tid & 63, isl = tid >> 6, c0 = ch * 64;
        float acc[8];
#pragma unroll
        for (int b = 0; b < 8; ++b) acc[b] = 0.f;
        for (int i0 = 0; i0 < 128; i0 += 16) {
            float wv[16];
#pragma unroll
            for (int u = 0; u < 16; ++u) wv[u] = p.w_ada[(size_t)(isl * 128 + i0 + u) * 6144 + c0 + col];
#pragma unroll
            for (int u = 0; u < 16; ++u) { const int i = isl * 128 + i0 + u;
#pragma unroll
                for (int b = 0; b < 8; ++b) acc[b] += sl[b * 1024 + i] * wv[u]; } }
#pragma unroll
        for (int b = 0; b < 8; ++b) red[(isl * 8 + b) * 64 + col] = acc[b];
        __syncthreads();
        { const int b = tid >> 6; float s_ = 0.f;
#pragma unroll
          for (int k = 0; k < 8; ++k) s_ += red[(k * 8 + b) * 64 + col];
          ((float*)(ws + WS_MOD))[b * 6144 + c0 + col] = s_ + p.b_ada[c0 + col]; }
        __syncthreads();
      }
    }
    for (int pn = G - 1 - bid; pn < 160; pn += G) {
        if (pn < 64) p0_quant_panel(p.w_pq, 2048, 32 * pn, ws + WS_WPQT, (float*)(ws + WS_CS) + 3072, 1.f, lds, tid);
        else { const int n0 = 32 * (pn - 64);
            p0_quant_panel(p.w_in, NPROJ, n0, ws + WS_WINT, (float*)(ws + WS_CS), (n0 < 512 || (n0 >= 1536 && n0 < 2048)) ? C2 : 1.f, lds, tid); } }
    {
        LAS float* scr = (LAS float*)(lds + wave * 16384);
        const int gw = bid * NWAVE + wave, NGW = G * NWAVE;
        constexpr int I_O = 16 * 32;
        for (int it = gw; it < I_O; it += NGW) p0_transpose_item(p.w_o, 1024, 1024, 1024, (bf16_t*)(ws + WS_WOT), scr, it, lane);
    }
    const int gt = bid * NTHR + tid, NGT = G * NTHR;
    for (int i = gt; i < 8192; i += NGT) { const int hh = i >> 10, k = i & 1023; ((float*)(ws + WS_WF))[i] = p.w_in[(size_t)k * NPROJ + NP + hh]; }
    for (int i = gt; i < 32768 / 2; i += NGT) { ((unsigned*)(ws + WS_SKB))[i] = pk2(p.sub_keys[2 * i], p.sub_keys[2 * i + 1]); }
    {
        const int gw = bid * NWAVE + wave, NGW = G * NWAVE;
        float* su = (float*)(ws + WS_SU);
        for (int e0 = gw; e0 < 16384; e0 += 2 * NGW) {
            f32x4 a[2][4];
#pragma unroll
            for (int u = 0; u < 2; ++u) { const int e = (e0 + u * NGW < 16384) ? e0 + u * NGW : e0;
#pragma unroll
                for (int k = 0; k < 4; ++k) a[u][k] = *(const f32x4*)(p.peer_u + (size_t)e * 1024 + lane * 16 + 4 * k); }
#pragma unroll
            for (int u = 0; u < 2; ++u) { const int e = e0 + u * NGW; if (e < 16384) {
                float am = 0.f;
#pragma unroll
                for (int k = 0; k < 4; ++k) am = fmaxf(am, fmaxf(fmaxf(fabsf(a[u][k][0]), fabsf(a[u][k][1])), fmaxf(fabsf(a[u][k][2]), fabsf(a[u][k][3]))));
                am = wave_max(am);
                const float sc = am > 0.f ? am * (1.f / 127.f) : 1.f, inv = 1.f / sc;
                v4u o;
#pragma unroll
                for (int k = 0; k < 4; ++k) { const int q0 = __float2int_rn(a[u][k][0] * inv), q1 = __float2int_rn(a[u][k][1] * inv), q2 = __float2int_rn(a[u][k][2] * inv), q3 = __float2int_rn(a[u][k][3] * inv);
                    o[k] = (unsigned)(q0 & 255) | ((unsigned)(q1 & 255) << 8) | ((unsigned)(q2 & 255) << 16) | ((unsigned)(q3 & 255) << 24); }
                *(v4u*)(ws + WS_PU + (size_t)(lane >> 3) * ((size_t)16384 * 128) + (size_t)e * 128 + (lane & 7) * 16) = o;
                if (lane == 0) su[e] = sc; } }
        }
    }
    constexpr int NIT = 16384 * 64;
    for (int i0 = gt; i0 < NIT; i0 += 4 * NGT) {
        f32x4 a[4][4];
#pragma unroll
        for (int u = 0; u < 4; ++u) { const int i = (i0 + u * NGT < NIT) ? i0 + u * NGT : i0; const int e = i >> 6, cc = i & 63;
            const float* src = p.peer_v + (size_t)e * 1024 + cc * 16;
#pragma unroll
            for (int k = 0; k < 4; ++k) a[u][k] = *(const f32x4*)(src + 4 * k); }
#pragma unroll
        for (int u = 0; u < 4; ++u) { const int i = i0 + u * NGT; if (i < NIT) { const int e = i >> 6, cc = i & 63;
            unsigned char* dst = ws + WS_PV + (size_t)(cc >> 3) * ((size_t)16384 * 128) + (size_t)e * 128 + (cc & 7) * 16;
            v4u o;
#pragma unroll
            for (int k = 0; k < 4; ++k) { int w = __builtin_amdgcn_cvt_pk_fp8_f32(a[u][k][0] * 64.f, a[u][k][1] * 64.f, 0, false); w = __builtin_amdgcn_cvt_pk_fp8_f32(a[u][k][2] * 64.f, a[u][k][3] * 64.f, w, true); o[k] = (unsigned)w; }
            *(v4u*)dst = o; } }
    }
}


namespace att {
typedef short bf16x8 __attribute__((ext_vector_type(8)));
typedef float f32x16 __attribute__((ext_vector_type(16)));
typedef short s16x4 __attribute__((ext_vector_type(4)));
typedef short v4i16_t __attribute__((ext_vector_type(4)));
constexpr int L_K = 0;
constexpr int L_V = 16384;
constexpr int L_WSF = 49152;
constexpr int L_NB = 51200;
constexpr int L_TBL = 67584;
constexpr int L_SCAN = 68096;
constexpr int L_STG = 70144;
constexpr int L_END = 135680;
static_assert(L_END <= LDS_BYTES, "attention LDS map");
__device__ __forceinline__ int crow(int r, int hi) { return (r & 3) + 8 * (r >> 2) + 4 * hi; }
__device__ __forceinline__ s16x4 vtr(const LAS unsigned char* p) { return __builtin_bit_cast(s16x4, __builtin_amdgcn_ds_read_tr16_b64_v4i16((LAS v4i16_t*)p)); }
__device__ __forceinline__ float xhalf_max(float m) { auto rr = __builtin_amdgcn_permlane32_swap(__float_as_uint(m), __float_as_uint(m), false, false); return fmaxf(__uint_as_float(rr[0]), __uint_as_float(rr[1])); }
__device__ __forceinline__ float xhalf_sum(float m) { auto rr = __builtin_amdgcn_permlane32_swap(__float_as_uint(m), __float_as_uint(m), false, false); return __uint_as_float(rr[0]) + __uint_as_float(rr[1]); }

__device__ __forceinline__ float max3f(float a, float b, float c) { float r; asm("v_max3_f32 %0, %1, %2, %3" : "=v"(r) : "v"(a), "v"(b), "v"(c)); return r; }
__device__ __forceinline__ float wave_min32(float v) {
    return half_min(v);
}
constexpr float RESC_THR = 8.f;
constexpr float PRUNE_THR = 24.f;

template <int DV, int MODE>
__device__ __forceinline__ void attn_pass(f32x16 (&o)[DV / 32], const bf16_t* __restrict__ proj, int b, int q0, int qcol, int kcol, int vcol, float kmax, LAS unsigned char* lds, int tid) {
    asm volatile("" : "+v"(tid));
    const int lane = tid & 63, wid = __builtin_amdgcn_readfirstlane(tid >> 6), r32 = lane & 31, hi = lane >> 5;
    const size_t rowbase = (size_t)b * S;
    bf16x8 qr[4];
    { const bf16_t* qp = proj + (rowbase + q0 + wid * 32 + r32) * NP + qcol + hi * 8;
#pragma unroll
      for (int d0 = 0; d0 < 4; ++d0) qr[d0] = *(const bf16x8*)(qp + d0 * 16); }
    asm volatile("" : "+v"(qr[0]), "+v"(qr[1]), "+v"(qr[2]), "+v"(qr[3]));
    float qkb = 0.f;
    if (MODE == 1) { float ssq = 0.f;
#pragma unroll
        for (int d0 = 0; d0 < 4; ++d0)
#pragma unroll
            for (int j = 0; j < 8; ++j) { const float f = bf2f((bf16_t)qr[d0][j]); ssq += f * f; }
        ssq = xhalf_sum(ssq);
        float mx = ssq;
        mx = half_max(mx);
        qkb = sqrtf(mx) * kmax * 1.0001f; }
    const int srow = tid >> 3, sch = tid & 7;
    const unsigned kgo = (unsigned)(srow * NP + kcol + sch * 8) * 2u;
    const int kw = sch * 1024 + ((srow + sch) & 63) * 16;
    constexpr int NVP = DV / 64;
    unsigned vgo[NVP]; int vw[NVP];
#pragma unroll
    for (int j = 0; j < NVP; ++j) { const int i = tid + 512 * j; const int row = (DV == 64) ? (i >> 3) : (i >> 4), ch = (DV == 64) ? (i & 7) : (i & 15);
        vgo[j] = (unsigned)(row * NP + vcol + ch * 8) * 2u; vw[j] = (ch >> 2) * 4096 + (row >> 4) * 1024 + (row & 15) * 64 + (ch & 3) * 16; }
    const unsigned char* slab0 = (const unsigned char*)(proj + rowbase * NP);
    v4u kreg, vreg[NVP];
    LAS float* wsf = (LAS float*)(lds + L_WSF) + wid * 64;
    const LAS float* nb = (const LAS float*)(lds + L_NB);
    const LAS float* tbl = (const LAS float*)(lds + L_TBL);
    volatile LAS unsigned* flags = (volatile LAS unsigned*)(lds + L_SCAN + 64);
    float m = 0.f, l = 0.f; bool first = true, wdone = false;
#pragma unroll
    for (int d0 = 0; d0 < DV / 32; ++d0)
#pragma unroll
        for (int r = 0; r < 16; ++r) o[d0][r] = 0.f;
    const int NT = (q0 + 256) / 64;
    const int qw0 = q0 + wid * 32, qabs = qw0 + r32;
    { const unsigned char* sl = slab0 + (size_t)(NT - 1) * 64 * NP * 2;
      kreg = *(const v4u*)(sl + kgo);
#pragma unroll
      for (int j = 0; j < NVP; ++j) vreg[j] = *(const v4u*)(sl + vgo[j]); }
    *(LAS v4u*)(lds + L_K + kw) = kreg;
#pragma unroll
    for (int j = 0; j < NVP; ++j) *(LAS v4u*)(lds + L_V + vw[j]) = vreg[j];
    if (MODE == 1 && tid < 8) flags[tid] = 0u;
    __syncthreads();
    const int vlane = ((lane >> 4) & 1) * 32 + (lane & 3) * 8 + (4 * hi + ((lane & 15) >> 2)) * 64;
    int cur = 0;
    for (int t = NT - 1; t >= 0; --t) {
        const int s0 = t * 64;
        if (t > 0) { const unsigned char* sl = slab0 + (size_t)(s0 - 64) * NP * 2;
            kreg = *(const v4u*)(sl + kgo);
#pragma unroll
            for (int j = 0; j < NVP; ++j) vreg[j] = *(const v4u*)(sl + vgo[j]); }
        if (s0 <= qw0 + 31 && !wdone) {
            f32x16 p0, p1;
            if (MODE == 1) {
#pragma unroll
                for (int g4 = 0; g4 < 4; ++g4) { const f32x4 a = *(const LAS f32x4*)(nb + s0 + 8 * g4 + 4 * hi), c = *(const LAS f32x4*)(nb + s0 + 32 + 8 * g4 + 4 * hi);
#pragma unroll
                    for (int e = 0; e < 4; ++e) { p0[4 * g4 + e] = a[e] - m; p1[4 * g4 + e] = c[e] - m; } }
            } else {
#pragma unroll
                for (int r = 0; r < 16; ++r) { p0[r] = -m; p1[r] = -m; } }
            const LAS unsigned char* kb = lds + L_K + cur * 8192;
            { bf16x8 ka[8];
#pragma unroll
              for (int d0 = 0; d0 < 4; ++d0) { const int c = 2 * d0 + hi;
                  ka[2 * d0] = *(const LAS bf16x8*)(kb + c * 1024 + ((r32 + c) & 63) * 16);
                  ka[2 * d0 + 1] = *(const LAS bf16x8*)(kb + c * 1024 + ((r32 + 32 + c) & 63) * 16); }
#pragma unroll
              for (int d0 = 0; d0 < 4; ++d0) { p0 = __builtin_amdgcn_mfma_f32_32x32x16_bf16(ka[2 * d0], qr[d0], p0, 0, 0, 0); p1 = __builtin_amdgcn_mfma_f32_32x32x16_bf16(ka[2 * d0 + 1], qr[d0], p1, 0, 0, 0); } }
            const LAS unsigned char* vb = lds + L_V + cur * 16384 + vlane;
            constexpr int ND = DV / 32;
            s16x4 fa[ND][2][2];
#pragma unroll
            for (int d0 = 0; d0 < (ND < 2 ? ND : 2); ++d0)
#pragma unroll
                for (int i = 0; i < 2; ++i) { fa[d0][i][0] = vtr(vb + d0 * 4096 + i * 1024); fa[d0][i][1] = vtr(vb + d0 * 4096 + i * 1024 + 512); }
            const bool band = (MODE == 0) ? (s0 + 63 + 112 >= qw0) : (s0 + 63 > qw0);
            if (band) {
                int qh = qabs - 4 * hi - s0; asm volatile("" : "+v"(qh));
#pragma unroll
                for (int r = 0; r < 16; ++r) { const int d0_ = qh - ((r & 3) + 8 * (r >> 2)), d1_ = d0_ - 32;
                    if (MODE == 0) { const float b0 = tbl[d0_ < 0 ? 0 : (d0_ > 127 ? 127 : d0_)], b1 = tbl[d1_ < 0 ? 0 : (d1_ > 127 ? 127 : d1_)];
                        p0[r] = d0_ < 0 ? -INFINITY : p0[r] + b0; p1[r] = d1_ < 0 ? -INFINITY : p1[r] + b1; }
                    else { p0[r] = d0_ < 0 ? -INFINITY : p0[r]; p1[r] = d1_ < 0 ? -INFINITY : p1[r]; } }
            }
            asm volatile("s_nop 15\n\ts_nop 7" : "+v"(p0), "+v"(p1));
            float ra = max3f(p0[0], p0[1], p1[0]), rb = max3f(p0[2], p0[3], p1[1]); ra = max3f(ra, p1[2], p1[3]);
#pragma unroll
            for (int r = 4; r < 16; r += 4) { ra = max3f(ra, p0[r], p0[r + 1]); rb = max3f(rb, p0[r + 2], p0[r + 3]); ra = max3f(ra, p1[r], p1[r + 1]); rb = max3f(rb, p1[r + 2], p1[r + 3]); }
            float rm = xhalf_max(fmaxf(ra, rb));
            if (first || __any(rm > RESC_THR)) {
                const float dl = first ? rm : fmaxf(rm, 0.f), alpha = first ? 1.f : __builtin_amdgcn_exp2f(-dl);
                m += dl; l *= alpha;
#pragma unroll
                for (int r = 0; r < 16; ++r) { p0[r] -= dl; p1[r] -= dl; }
                if (!first) {
                    if (hi == 0) wsf[r32] = alpha;
                    asm volatile("s_waitcnt lgkmcnt(0)" ::: "memory");
#pragma unroll
                    for (int r = 0; r < 16; ++r) { const float f = wsf[crow(r, hi)];
#pragma unroll
                        for (int d0 = 0; d0 < DV / 32; ++d0) o[d0][r] *= f; }
                }
                first = false;
            }
            float rs = 0.f;
#pragma unroll
            for (int r = 0; r < 16; ++r) { p0[r] = __builtin_amdgcn_exp2f(p0[r]); rs += p0[r]; }
            v4u pw[4];
#pragma unroll
            for (int i = 0; i < 4; ++i) { pw[0][i] = pg8::cvt_pk_bf16(p0[2 * i], p0[2 * i + 1]); pw[1][i] = pg8::cvt_pk_bf16(p0[8 + 2 * i], p0[8 + 2 * i + 1]); }
#pragma unroll
            for (int d0 = 2; d0 < ND; ++d0)
#pragma unroll
                for (int i = 0; i < 2; ++i) { fa[d0][i][0] = vtr(vb + d0 * 4096 + i * 1024); fa[d0][i][1] = vtr(vb + d0 * 4096 + i * 1024 + 512); }
            __builtin_amdgcn_sched_barrier(0);
#pragma unroll
            for (int d0 = 0; d0 < ND; ++d0) {
#pragma unroll
                for (int i = 0; i < 2; ++i) { const s16x4 a_ = fa[d0][i][0], b_ = fa[d0][i][1]; const bf16x8 vf = (bf16x8){a_[0], a_[1], a_[2], a_[3], b_[0], b_[1], b_[2], b_[3]};
                    o[d0] = __builtin_amdgcn_mfma_f32_32x32x16_bf16(__builtin_bit_cast(bf16x8, pw[i]), vf, o[d0], 0, 0, 0); }
                __builtin_amdgcn_sched_barrier(0);
#pragma unroll
                for (int i = 0; i < 2; ++i) { fa[d0][i][0] = vtr(vb + d0 * 4096 + (2 + i) * 1024); fa[d0][i][1] = vtr(vb + d0 * 4096 + (2 + i) * 1024 + 512); }
#pragma unroll
                for (int r = d0 * (16 / ND); r < (d0 + 1) * (16 / ND); ++r) { p1[r] = __builtin_amdgcn_exp2f(p1[r]); rs += p1[r]; }
                __builtin_amdgcn_sched_barrier(0);
            }
            l += rs;
#pragma unroll
            for (int i = 0; i < 4; ++i) { pw[2][i] = pg8::cvt_pk_bf16(p1[2 * i], p1[2 * i + 1]); pw[3][i] = pg8::cvt_pk_bf16(p1[8 + 2 * i], p1[8 + 2 * i + 1]); }
#pragma unroll
            for (int d0 = 0; d0 < ND; ++d0)
#pragma unroll
                for (int i = 0; i < 2; ++i) { const s16x4 a_ = fa[d0][i][0], b_ = fa[d0][i][1]; const bf16x8 vf = (bf16x8){a_[0], a_[1], a_[2], a_[3], b_[0], b_[1], b_[2], b_[3]};
                    o[d0] = __builtin_amdgcn_mfma_f32_32x32x16_bf16(__builtin_bit_cast(bf16x8, pw[2 + i]), vf, o[d0], 0, 0, 0); }
        }
        if (t > 0) { *(LAS v4u*)(lds + L_K + (cur ^ 1) * 8192 + kw) = kreg;
#pragma unroll
            for (int j = 0; j < NVP; ++j) *(LAS v4u*)(lds + L_V + (cur ^ 1) * 16384 + vw[j]) = vreg[j]; }
        if (MODE == 1 && t > 0 && !wdone && !first && (s0 - 1 < qw0)) {
            const float ub = qkb + nb[s0 - 1];
            if (ub < wave_min32(m) - PRUNE_THR) { wdone = true; if (lane == 0) flags[wid] = 1u; }
        }
        __syncthreads();
        if (MODE == 1) { const unsigned all = flags[0] & flags[1] & flags[2] & flags[3] & flags[4] & flags[5] & flags[6] & flags[7]; if (all) break; }
        cur ^= 1;
    }
    if (MODE == 1) __syncthreads();
    l = xhalf_sum(l);
    if (hi == 0) wsf[r32] = 1.f / l;
    asm volatile("s_waitcnt lgkmcnt(0)" ::: "memory");
#pragma unroll
    for (int r = 0; r < 16; ++r) { const float f = wsf[crow(r, hi)];
#pragma unroll
        for (int d0 = 0; d0 < DV / 32; ++d0) o[d0][r] *= f; }
}

__device__ __forceinline__ void fox_kmax(const Params& p, int b, int h, LAS unsigned char* lds, int tid) {
    const bf16_t* kb = (const bf16_t*)(p.ws + WS_PROJ) + (size_t)b * S * NP + 2048 + h * 64;
    float mx = 0.f;
    for (int s = tid; s < S; s += NTHR) { float ss = 0.f;
#pragma unroll
        for (int c = 0; c < 8; ++c) { const v4u w = *(const v4u*)(kb + (size_t)s * NP + c * 8);
#pragma unroll
            for (int k = 0; k < 4; ++k) { const float f0 = __uint_as_float(w[k] << 16), f1 = __uint_as_float(w[k] & 0xffff0000u); ss += f0 * f0 + f1 * f1; } }
        mx = fmaxf(mx, ss); }
    mx = wave_max(mx);
    LAS float* sc = (LAS float*)(lds + L_SCAN);
    if ((tid & 63) == 0) sc[48 + (tid >> 6)] = mx;
    __syncthreads();
    if (tid == 0) { float v = sc[48];
        for (int w = 1; w < 8; ++w) v = fmaxf(v, sc[48 + w]);
        sc[32] = sqrtf(v); }
    __syncthreads();
}

template <int NC>
__device__ __forceinline__ void stage_store(LAS unsigned char* stg, bf16_t* gbase  , int lane) {
    asm volatile("" : "+v"(lane));
    asm volatile("s_waitcnt lgkmcnt(0)" ::: "memory");
    constexpr int CPR = NC / 8;
#pragma unroll
    for (int i = 0; i < 32 * CPR / 64; ++i) { const int idx = i * 64 + lane, row = idx / CPR, ch = idx % CPR;
        const v4u v = *(const LAS v4u*)(stg + row * (NC * 2) + ch * 16); *(v4u*)(gbase + (size_t)row * D + ch * 8) = v; }
    asm volatile("s_waitcnt lgkmcnt(0)" ::: "memory");
}

__device__ __forceinline__ void fox_unit(const Params& p, int b, int h, int qb, LAS unsigned char* lds, int tid) {
    const int lane = tid & 63, wid = __builtin_amdgcn_readfirstlane(tid >> 6), r32 = lane & 31, hi = lane >> 5;
    const int q0 = qb * 256, n = q0 + 256;
    const bf16_t* proj = (const bf16_t*)(p.ws + WS_PROJ);
    { LAS float* nbw = (LAS float*)(lds + L_NB); LAS float* sc = (LAS float*)(lds + L_SCAN);
      const float* lf = (const float*)(p.ws + WS_LOGF) + (size_t)b * S * 8 + h;
      float v[8]; float run = 0.f;
#pragma unroll
      for (int e = 0; e < 8; ++e) { const int s = tid * 8 + e; const float x = (s < n) ? lf[(size_t)s * 8] : 0.f; run += x; v[e] = run; }
      float inc = run;
      { float tot = run;
#define FX_STEP(O) { const float t_ = shx<O>(tot); if (lane & O) inc += t_; tot += t_; }
        FX_STEP(1) FX_STEP(2) FX_STEP(4) FX_STEP(8) FX_STEP(16) FX_STEP(32)
#undef FX_STEP
      }
      if (lane == 63) sc[wid] = inc;
      __syncthreads();
      float base = inc - run;
      for (int w = 0; w < wid; ++w) base += sc[w];
#pragma unroll
      for (int e = 0; e < 8; ++e) nbw[tid * 8 + e] = base + v[e];
      __syncthreads();
      const float ref = (q0 > 0) ? nbw[q0 - 1] : 0.f;
      __syncthreads();
#pragma unroll
      for (int e = 0; e < 8; ++e) nbw[tid * 8 + e] = -(base + v[e] - ref) * 1.4426950408889634f;
      __syncthreads(); }
    f32x16 o[2];
    attn_pass<64, 1>(o, proj, b, q0, 1536 + h * 64, 2048 + h * 64, 2560 + h * 64, *(const LAS float*)(lds + L_SCAN + 128), lds, tid);
    LAS unsigned char* stg = lds + L_STG + wid * 8192;
    { int sb = hi * 512 + r32 * 2; asm volatile("" : "+v"(sb));
#pragma unroll
    for (int r = 0; r < 16; ++r)
#pragma unroll
        for (int d0 = 0; d0 < 2; ++d0) *(LAS bf16_t*)(stg + sb + ((r & 3) + 8 * (r >> 2)) * 128 + d0 * 64) = f2bf(o[d0][r]); }
    stage_store<64>(stg, (bf16_t*)(p.ws + WS_OCAT) + ((size_t)b * S + q0 + wid * 32) * D + 512 + h * 64, lane);
}

__device__ __forceinline__ void diff_unit(const Params& p, int b, int h, int qb, float lam, LAS unsigned char* lds, int tid) {
    const int lane = tid & 63, wid = __builtin_amdgcn_readfirstlane(tid >> 6), r32 = lane & 31, hi = lane >> 5;
    const int q0 = qb * 256;
    const bf16_t* proj = (const bf16_t*)(p.ws + WS_PROJ);
    if (tid < 128) { LAS float* tb = (LAS float*)(lds + L_TBL); tb[tid] = (p.rel_bias[t5_bucket(tid) * 4 + h] - p.rel_bias[31 * 4 + h]) * 1.4426950408889634f; }
    __syncthreads();
    LAS unsigned char* stg = lds + L_STG + wid * 8192;
    f32x16 o[4];
    attn_pass<128, 0>(o, proj, b, q0, h * 128, 512 + h * 128, 1024 + h * 128, 0.f, lds, tid);
    { int sb = hi * 1024 + r32 * 2; asm volatile("" : "+v"(sb));
#pragma unroll
    for (int d0 = 0; d0 < 4; ++d0)
#pragma unroll
        for (int r = 0; r < 16; ++r) *(LAS bf16_t*)(stg + sb + ((r & 3) + 8 * (r >> 2)) * 256 + d0 * 64) = f2bf(o[d0][r]); }
    attn_pass<128, 0>(o, proj, b, q0, h * 128 + 64, 512 + h * 128 + 64, 1024 + h * 128, 0.f, lds, tid);
    float ss[16];
#pragma unroll
    for (int r = 0; r < 16; ++r) ss[r] = 0.f;
    int sb2 = hi * 1024 + r32 * 2; asm volatile("" : "+v"(sb2));
#pragma unroll
    for (int d0 = 0; d0 < 4; ++d0)
#pragma unroll
        for (int r = 0; r < 16; ++r) { const float a0 = bf2f(*(const LAS bf16_t*)(stg + sb2 + ((r & 3) + 8 * (r >> 2)) * 256 + d0 * 64));
            const float e0 = a0 - lam * o[d0][r]; o[d0][r] = e0; ss[r] += e0 * e0; }
#pragma unroll
    for (int r = 0; r < 16; ++r) {
        ss[r] = half_sum(ss[r]);
        ss[r] = rsqrtf(ss[r] * (1.f / 128.f) + EPS) * 0.8f; }
#pragma unroll
    for (int d0 = 0; d0 < 4; ++d0) { const float gg = p.g_subln[d0 * 32 + r32];
#pragma unroll
        for (int r = 0; r < 16; ++r) *(LAS bf16_t*)(stg + sb2 + ((r & 3) + 8 * (r >> 2)) * 256 + d0 * 64) = f2bf(o[d0][r] * ss[r] * gg); }
    stage_store<128>(stg, (bf16_t*)(p.ws + WS_OCAT) + ((size_t)b * S + q0 + wid * 32) * D + h * 128, lane);
}

__device__ __forceinline__ void attn_phase(const Params& p, LAS unsigned char* lds) {
    const int tid = otid(), lane = tid & 63, G = gridDim.x, bx = blockIdx.x;
    const int vcu = (G % 8 == 0) ? (bx % 8) * (G / 8) + bx / 8 : bx;
    const float lam = expf(wave_sum(p.lq1[lane] * p.lk1[lane])) - expf(wave_sum(p.lq2[lane] * p.lk2[lane])) + 0.2f;
    for (int slot = vcu; slot < 256; slot += G) {
        { const int bh = slot >> 3, s = slot & 7;
          for (int i = 0; i < 2; ++i) diff_unit(p, bh >> 2, bh & 3, i == 0 ? 15 - s : s, lam, lds, tid); }
        { const int bh = slot >> 2, s = slot & 3; const int b = bh >> 3, h = bh & 7;
          fox_kmax(p, b, h, lds, tid);
          for (int i = 0; i < 4; ++i) { const int qb = (i == 0) ? 15 - s : (i == 1) ? 8 + s : (i == 2) ? 7 - s : s; fox_unit(p, b, h, qb, lds, tid); } }
    }
}
}


namespace tk {
typedef short bf16x8 __attribute__((ext_vector_type(8)));
typedef float f32x16 __attribute__((ext_vector_type(16)));
constexpr int L_SK = 0;
constexpr int L_TAB = 65536;
#define TK_CE(a, b) do { const float t_ = __builtin_fmaxf(a, b); b = __builtin_fminf(a, b); a = t_; } while (0)
__device__ __forceinline__ void sort16(float (&v)[16]) {
    TK_CE(v[0], v[1]); TK_CE(v[2], v[3]); TK_CE(v[0], v[2]); TK_CE(v[1], v[3]); TK_CE(v[1], v[2]); TK_CE(v[4], v[5]); TK_CE(v[6], v[7]); TK_CE(v[4], v[6]); TK_CE(v[5], v[7]); TK_CE(v[5], v[6]); TK_CE(v[0], v[4]); TK_CE(v[2], v[6]); TK_CE(v[2], v[4]); TK_CE(v[1], v[5]); TK_CE(v[3], v[7]); TK_CE(v[3], v[5]); TK_CE(v[1], v[2]); TK_CE(v[3], v[4]); TK_CE(v[5], v[6]); TK_CE(v[8], v[9]); TK_CE(v[10], v[11]); TK_CE(v[8], v[10]); TK_CE(v[9], v[11]); TK_CE(v[9], v[10]); TK_CE(v[12], v[13]); TK_CE(v[14], v[15]); TK_CE(v[12], v[14]); TK_CE(v[13], v[15]); TK_CE(v[13], v[14]); TK_CE(v[8], v[12]); TK_CE(v[10], v[14]); TK_CE(v[10], v[12]); TK_CE(v[9], v[13]); TK_CE(v[11], v[15]); TK_CE(v[11], v[13]); TK_CE(v[9], v[10]); TK_CE(v[11], v[12]); TK_CE(v[13], v[14]); TK_CE(v[0], v[8]); TK_CE(v[4], v[12]); TK_CE(v[4], v[8]); TK_CE(v[2], v[10]); TK_CE(v[6], v[14]); TK_CE(v[6], v[10]); TK_CE(v[2], v[4]); TK_CE(v[6], v[8]); TK_CE(v[10], v[12]); TK_CE(v[1], v[9]); TK_CE(v[5], v[13]); TK_CE(v[5], v[9]); TK_CE(v[3], v[11]); TK_CE(v[7], v[15]); TK_CE(v[7], v[11]); TK_CE(v[3], v[5]); TK_CE(v[7], v[9]); TK_CE(v[11], v[13]); TK_CE(v[1], v[2]); TK_CE(v[3], v[4]); TK_CE(v[5], v[6]); TK_CE(v[7], v[8]); TK_CE(v[9], v[10]); TK_CE(v[11], v[12]); TK_CE(v[13], v[14]);
}
__device__ __forceinline__ void merge8x8(float (&v)[16]) {
    TK_CE(v[0], v[8]); TK_CE(v[4], v[12]); TK_CE(v[4], v[8]); TK_CE(v[2], v[10]); TK_CE(v[6], v[14]); TK_CE(v[6], v[10]); TK_CE(v[2], v[4]); TK_CE(v[6], v[8]); TK_CE(v[10], v[12]); TK_CE(v[1], v[9]); TK_CE(v[5], v[13]); TK_CE(v[5], v[9]); TK_CE(v[3], v[11]); TK_CE(v[7], v[15]); TK_CE(v[7], v[11]); TK_CE(v[3], v[5]); TK_CE(v[7], v[9]); TK_CE(v[11], v[13]); TK_CE(v[1], v[2]); TK_CE(v[3], v[4]); TK_CE(v[5], v[6]); TK_CE(v[7], v[8]); TK_CE(v[9], v[10]); TK_CE(v[11], v[12]); TK_CE(v[13], v[14]);
}
__device__ __forceinline__ void merge16(float (&a)[16], const float (&b)[16]) {
#pragma unroll
    for (int i = 0; i < 16; ++i) a[i] = __builtin_fmaxf(a[i], b[15 - i]);
#pragma unroll
    for (int j = 8; j > 0; j >>= 1)
#pragma unroll
        for (int i = 0; i < 16; ++i) { const int l = i ^ j; if (l > i) TK_CE(a[i], a[l]); }
}
__device__ __forceinline__ void load_q(bf16x8 (&qb)[8], const bf16_t* __restrict__ qrow) {
#pragma unroll
    for (int ks = 0; ks < 8; ++ks) qb[ks] = *(const bf16x8*)(qrow + ks * 16);
}
__device__ __forceinline__ void side_scores(f32x16 (&acc)[4], const bf16x8 (&qb)[8], const LAS unsigned char* skp, int r32, int hi) {
#pragma unroll
    for (int mt = 0; mt < 4; ++mt) {
#pragma unroll
        for (int r = 0; r < 16; ++r) acc[mt][r] = 0.f;
#pragma unroll
        for (int ks = 0; ks < 8; ++ks) { const bf16x8 a = *(const LAS bf16x8*)(skp + (2 * ks + hi) * 2048 + (32 * mt + r32) * 16);
            acc[mt] = __builtin_amdgcn_mfma_f32_32x32x16_bf16(a, qb[ks], acc[mt], 0, 0, 0); } }
}
__device__ __forceinline__ void side_top16(float (&top)[16], const f32x16 (&acc)[4], int hi) {
    float w[16];
#pragma unroll
    for (int mt = 0; mt < 4; ++mt) {
        float* dst = (mt == 0) ? top : w;
#pragma unroll
        for (int r = 0; r < 16; ++r) { const unsigned n = 32 * mt + (r & 3) + 8 * (r >> 2) + 4 * hi; dst[r] = __uint_as_float((__float_as_uint(acc[mt][r]) & ~127u) | n); }
        if (mt == 0) sort16(top); else { sort16(w); merge16(top, w); }
    }
    float a0[16], a1[16];
#pragma unroll
    for (int i = 0; i < 16; ++i) { auto rr = __builtin_amdgcn_permlane32_swap(__float_as_uint(top[i]), __float_as_uint(top[i]), false, false); a0[i] = __uint_as_float(rr[0]); a1[i] = __uint_as_float(rr[1]); }
    merge16(a0, a1);
#pragma unroll
    for (int i = 0; i < 16; ++i) top[i] = a0[i];
}

__device__ __forceinline__ void topk_phase(const Params& p, LAS unsigned char* lds) {
    const int tid = otid(), lane = tid & 63, wave = __builtin_amdgcn_readfirstlane(tid >> 6), r32 = lane & 31, hi = lane >> 5, G = gridDim.x;
    { const v4u* src = (const v4u*)(p.ws + WS_SKB);
      for (int i = tid; i < 4096; i += NTHR) { const int pp = i >> 11, n = (i >> 4) & 127, c = i & 15; *(LAS v4u*)(lds + L_SK + pp * 32768 + c * 2048 + n * 16) = src[i]; }
      __syncthreads(); }
    const bf16_t* pq = (const bf16_t*)(p.ws + WS_PQ);
    bf16_t* ids = (bf16_t*)(p.ws + WS_IDS); float* gout = (float*)(p.ws + WS_G);
    LAS unsigned char* tab = lds + L_TAB + wave * 2048 + lane * 32;
    bf16x8 q0[8], q1[8];
    { const int item0 = blockIdx.x * NWAVE + wave; if (item0 < T * 8 / 32) { const bf16_t* qrow = pq + ((size_t)item0 * 32 + r32) * 256 + hi * 8; load_q(q0, qrow); load_q(q1, qrow + 128); } }
    for (int item = blockIdx.x * NWAVE + wave; item < T * 8 / 32; item += G * NWAVE) {
        const size_t row = (size_t)item * 32 + r32;
        float s0[16], s1[16];
        { f32x16 acc[4]; side_scores(acc, q0, lds + L_SK, r32, hi); side_top16(s0, acc, hi); }
        { f32x16 acc[4]; side_scores(acc, q1, lds + L_SK + 32768, r32, hi);
          { const int nxt = item + G * NWAVE; const int ic = nxt < T * 8 / 32 ? nxt : item;
            const bf16_t* qrow = pq + ((size_t)ic * 32 + r32) * 256 + hi * 8; load_q(q0, qrow); load_q(q1, qrow + 128); }
          side_top16(s1, acc, hi); }
#pragma unroll
        for (int i = 0; i < 16; i += 4) {
            *(LAS unsigned*)(tab + i) = (__float_as_uint(s0[i]) & 127u) | ((__float_as_uint(s0[i + 1]) & 127u) << 8) | ((__float_as_uint(s0[i + 2]) & 127u) << 16) | ((__float_as_uint(s0[i + 3]) & 127u) << 24);
            *(LAS unsigned*)(tab + 16 + i) = (__float_as_uint(s1[i]) & 127u) | ((__float_as_uint(s1[i + 1]) & 127u) << 8) | ((__float_as_uint(s1[i + 2]) & 127u) << 16) | ((__float_as_uint(s1[i + 3]) & 127u) << 24); }
        float c0[16], c1[16], c2[16], c3[16];
#define TK_C(i, j) __uint_as_float((__float_as_uint(s0[i] + s1[j]) & ~255u) | (unsigned)((i) * 16 + (j)))
        c0[0] = TK_C(0, 0); c0[1] = TK_C(0, 1); c0[2] = TK_C(0, 2); c0[3] = TK_C(0, 3); c0[4] = TK_C(0, 4); c0[5] = TK_C(0, 5); c0[6] = TK_C(0, 6); c0[7] = TK_C(0, 7);
        c0[8] = TK_C(0, 8); c0[9] = TK_C(0, 9); c0[10] = TK_C(0, 10); c0[11] = TK_C(0, 11); c0[12] = TK_C(0, 12); c0[13] = TK_C(0, 13); c0[14] = TK_C(0, 14); c0[15] = TK_C(0, 15);
        c1[0] = TK_C(1, 0); c1[1] = TK_C(1, 1); c1[2] = TK_C(1, 2); c1[3] = TK_C(1, 3); c1[4] = TK_C(1, 4); c1[5] = TK_C(1, 5); c1[6] = TK_C(1, 6); c1[7] = TK_C(1, 7);
        c1[8] = TK_C(8, 0); c1[9] = TK_C(9, 0); c1[10] = TK_C(10, 0); c1[11] = TK_C(11, 0); c1[12] = TK_C(12, 0); c1[13] = TK_C(13, 0); c1[14] = TK_C(14, 0); c1[15] = TK_C(15, 0);
        c2[0] = TK_C(2, 0); c2[1] = TK_C(2, 1); c2[2] = TK_C(2, 2); c2[3] = TK_C(2, 3); c2[4] = TK_C(2, 4); c2[5] = TK_C(3, 0); c2[6] = TK_C(3, 1); c2[7] = TK_C(3, 2);
        c2[8] = TK_C(3, 3); c2[9] = TK_C(4, 0); c2[10] = TK_C(4, 1); c2[11] = TK_C(4, 2); c2[12] = TK_C(5, 0); c2[13] = TK_C(5, 1); c2[14] = TK_C(6, 0); c2[15] = TK_C(6, 1);
        c3[0] = TK_C(7, 0); c3[1] = TK_C(7, 1);
#pragma unroll
        for (int i = 2; i < 16; ++i) c3[i] = -INFINITY;
#undef TK_C
        merge8x8(c1); merge16(c0, c1); sort16(c2); merge16(c2, c3); merge16(c0, c2);
        float e[16], sum = 0.f;
#pragma unroll
        for (int k = 0; k < 16; ++k) { e[k] = __expf(c0[k] - c0[0]); sum += e[k]; }
        const float inv = 1.f / sum;
        unsigned idv[16];
#pragma unroll
        for (int k = 0; k < 16; ++k) { const unsigned ij = __float_as_uint(c0[k]) & 255u; const unsigned n0 = *(const LAS unsigned char*)(tab + (ij >> 4)), n1 = *(const LAS unsigned char*)(tab + 16 + (ij & 15u)); idv[k] = n0 * 128u + n1; }
        if (hi == 0) {
#pragma unroll
            for (int k = 0; k < 16; k += 8) *(v4u*)(ids + row * 16 + k) = (v4u){idv[k] | (idv[k + 1] << 16), idv[k + 2] | (idv[k + 3] << 16), idv[k + 4] | (idv[k + 5] << 16), idv[k + 6] | (idv[k + 7] << 16)};
#pragma unroll
            for (int k = 0; k < 16; k += 4) *(f32x4*)(gout + row * 16 + k) = (f32x4){e[k] * inv, e[k + 1] * inv, e[k + 2] * inv, e[k + 3] * inv};
        }
    }
}
}


namespace rw {
typedef __bf16 bf16x2 __attribute__((ext_vector_type(2)));
__device__ __forceinline__ float dot2(unsigned a, unsigned b, float c) { return __builtin_amdgcn_fdot2_f32_bf16(__builtin_bit_cast(bf16x2, a), __builtin_bit_cast(bf16x2, b), c, false); }

constexpr int RW = 4;
__device__ __forceinline__ f32x4 bf4(uint2 w) { return (f32x4){__uint_as_float(w.x << 16), __uint_as_float(w.x & 0xffff0000u), __uint_as_float(w.y << 16), __uint_as_float(w.y & 0xffff0000u)}; }
__device__ __forceinline__ void norm1_phase(const Params& p, LAS unsigned char* lds) {
    const int tid = otid(), lane = tid & 63, wave = tid >> 6;
    const float* mod = (const float*)(p.ws + WS_MOD);
    unsigned char* hout = p.ws + WS_H; float* logf_ = (float*)(p.ws + WS_LOGF);
    { const f32x4* src = (const f32x4*)(p.ws + WS_WF); LAS f32x4* dst = (LAS f32x4*)lds; for (int i = tid; i < 2048; i += NTHR) dst[i] = src[i]; }
    __syncthreads();
    const LAS float* wf = (const LAS float*)lds;
    const int rpb = (T + gridDim.x - 1) / gridDim.x, r0 = blockIdx.x * rpb, r1 = (r0 + rpb < T) ? r0 + rpb : T;
    int cb = -1; f32x4 ga[4], sh[4];
    for (int t0 = r0 + wave; t0 < r1; t0 += NWAVE * RW) {
        f32x4 xv[RW][4];
#pragma unroll
        for (int i = 0; i < RW; ++i) { const int t = t0 + i * NWAVE < r1 ? t0 + i * NWAVE : t0;
#pragma unroll
            for (int j = 0; j < 4; ++j) xv[i][j] = *(const f32x4*)(p.x + (size_t)t * D + lane * 4 + 256 * j); }
#pragma unroll
        for (int i = 0; i < RW; ++i) { const int t = t0 + i * NWAVE; if (t < r1) {
            const int bb = __builtin_amdgcn_readfirstlane(t / S);
            if (bb != cb) { cb = bb; const float* mb = mod + bb * 6144;
#pragma unroll
                for (int j = 0; j < 4; ++j) { const int col = lane * 4 + 256 * j; ga[j] = *(const f32x4*)(p.g_pre_mix + col) * (*(const f32x4*)(mb + 1024 + col) + 1.f); sh[j] = *(const f32x4*)(mb + col); } }
            f32x4 (&v)[4] = xv[i]; float ss = 0.f;
#pragma unroll
            for (int j = 0; j < 4; ++j) ss += v[j][0] * v[j][0] + v[j][1] * v[j][1] + v[j][2] * v[j][2] + v[j][3] * v[j][3];
            ss = wave_sum(ss); const float r = rsqrtf(ss * (1.f / D) + EPS);
            float am = 0.f;
#pragma unroll
            for (int j = 0; j < 4; ++j) { v[j] = v[j] * r * ga[j] + sh[j]; am = fmaxf(am, fmaxf(fmaxf(fabsf(v[j][0]), fabsf(v[j][1])), fmaxf(fabsf(v[j][2]), fabsf(v[j][3])))); }
            am = wave_max(am);
            { const float qs = am > 0.f ? am * (1.f / 127.f) : 1.f, qi = 1.f / qs;
#pragma unroll
              for (int j = 0; j < 4; ++j) { const int col = lane * 4 + 256 * j; const int q0 = __float2int_rn(v[j][0] * qi), q1 = __float2int_rn(v[j][1] * qi), q2 = __float2int_rn(v[j][2] * qi), q3 = __float2int_rn(v[j][3] * qi);
                  *(unsigned*)(hout + (size_t)t * D + col) = (unsigned)(q0 & 255) | ((unsigned)(q1 & 255) << 8) | ((unsigned)(q2 & 255) << 16) | ((unsigned)(q3 & 255) << 24); }
              if (lane == 0) ((float*)(p.ws + WS_S1))[t] = qs; }
            float d8[8];
#pragma unroll
            for (int hq = 0; hq < 4; ++hq) {
#pragma unroll
                for (int h2_ = 0; h2_ < 2; ++h2_) { const int hh = 2 * hq + h2_; float s_ = 0.f;
#pragma unroll
                    for (int j = 0; j < 4; ++j) { const f32x4 w = *(const LAS f32x4*)(wf + hh * 1024 + lane * 4 + 256 * j); s_ += v[j][0] * w[0] + v[j][1] * w[1] + v[j][2] * w[2] + v[j][3] * w[3]; }
                    d8[hh] = s_; }
                __builtin_amdgcn_sched_barrier(0); }
            float q4[4], q2[2], z;
#pragma unroll
            for (int k = 0; k < 4; ++k) { const float snd = (lane & 32) ? d8[k] : d8[k + 4]; q4[k] = ((lane & 32) ? d8[k + 4] : d8[k]) + shx<32>(snd); }
#pragma unroll
            for (int k = 0; k < 2; ++k) { const float snd = (lane & 16) ? q4[k] : q4[k + 2]; q2[k] = ((lane & 16) ? q4[k + 2] : q4[k]) + shx<16>(snd); }
            { const float snd = (lane & 8) ? q2[0] : q2[1]; z = ((lane & 8) ? q2[1] : q2[0]) + shx<8>(snd); }
            z += shx<4>(z); z += shx<2>(z); z += shx<1>(z);
            if ((lane & 7) == 0) { const int hh = ((lane >> 5) & 1) * 4 + ((lane >> 4) & 1) * 2 + ((lane >> 3) & 1); z += p.b_f[hh]; logf_[(size_t)t * 8 + hh] = -(fmaxf(-z, 0.f) + log1pf(expf(-fabsf(z)))); }
        } }
    }
    __syncthreads();
}
__device__ __forceinline__ void post1_phase(const Params& p) {
    const int tid = otid(), lane = tid & 63, wave = tid >> 6;
    const float* mod = (const float*)(p.ws + WS_MOD); const bf16_t* y = (const bf16_t*)(p.ws + WS_PROJ);
    const int rpb = (T + gridDim.x - 1) / gridDim.x, r0 = blockIdx.x * rpb, r1 = (r0 + rpb < T) ? r0 + rpb : T;
    int cb = -1; f32x4 ga[4], gb[4], sh[4];
    for (int t0 = r0 + wave; t0 < r1; t0 += NWAVE * RW) {
        f32x4 xa[RW][4]; uint2 ya[RW][4];
#pragma unroll
        for (int i = 0; i < RW; ++i) { const int t = t0 + i * NWAVE < r1 ? t0 + i * NWAVE : t0;
#pragma unroll
            for (int j = 0; j < 4; ++j) { ya[i][j] = *(const uint2*)(y + (size_t)t * D + lane * 4 + 256 * j); xa[i][j] = *(const f32x4*)(p.x + (size_t)t * D + lane * 4 + 256 * j); } }
#pragma unroll
        for (int i = 0; i < RW; ++i) { const int t = t0 + i * NWAVE; if (t < r1) {
            const int bb = __builtin_amdgcn_readfirstlane(t / S);
            if (bb != cb) { cb = bb; const float* mb = mod + bb * 6144;
#pragma unroll
                for (int j = 0; j < 4; ++j) { const int col = lane * 4 + 256 * j; ga[j] = *(const f32x4*)(p.g_post_mix + col) * *(const f32x4*)(mb + 2048 + col);
                    gb[j] = *(const f32x4*)(p.g_pre_ffn + col) * (*(const f32x4*)(mb + 4096 + col) + 1.f); sh[j] = *(const f32x4*)(mb + 3072 + col); } }
            f32x4 (&xv)[4] = xa[i]; f32x4 yv[4]; float ss = 0.f;
#pragma unroll
            for (int j = 0; j < 4; ++j) { yv[j] = bf4(ya[i][j]); ss += yv[j][0] * yv[j][0] + yv[j][1] * yv[j][1] + yv[j][2] * yv[j][2] + yv[j][3] * yv[j][3]; }
            ss = wave_sum(ss); const float r = rsqrtf(ss * (1.f / D) + EPS); float s2 = 0.f;
#pragma unroll
            for (int j = 0; j < 4; ++j) { const int col = lane * 4 + 256 * j; xv[j] = xv[j] + yv[j] * r * ga[j]; s2 += xv[j][0] * xv[j][0] + xv[j][1] * xv[j][1] + xv[j][2] * xv[j][2] + xv[j][3] * xv[j][3];
                *(uint2*)((bf16_t*)(p.ws + WS_X1) + (size_t)t * D + col) = make_uint2(pk2(xv[j][0], xv[j][1]), pk2(xv[j][2], xv[j][3])); }
            s2 = wave_sum(s2); const float r2 = rsqrtf(s2 * (1.f / D) + EPS);
            float am = 0.f;
#pragma unroll
            for (int j = 0; j < 4; ++j) { const int col = lane * 4 + 256 * j; const f32x4 o = xv[j] * r2 * gb[j] + sh[j]; xv[j] = o;
                am = fmaxf(am, fmaxf(fmaxf(fabsf(o[0]), fabsf(o[1])), fmaxf(fabsf(o[2]), fabsf(o[3])))); }
            am = wave_max(am);
            const float qs = am > 0.f ? am * (1.f / 127.f) : 1.f, qi = 1.f / qs;
#pragma unroll
            for (int j = 0; j < 4; ++j) { const int col = lane * 4 + 256 * j; const int q0 = __float2int_rn(xv[j][0] * qi), q1 = __float2int_rn(xv[j][1] * qi), q2 = __float2int_rn(xv[j][2] * qi), q3 = __float2int_rn(xv[j][3] * qi);
                *(unsigned*)(p.ws + WS_H8 + (size_t)t * D + col) = (unsigned)(q0 & 255) | ((unsigned)(q1 & 255) << 8) | ((unsigned)(q2 & 255) << 16) | ((unsigned)(q3 & 255) << 24); }
            if (lane == 0) ((float*)(p.ws + WS_SH))[t] = qs;
        } }
    }
}

}


namespace sh {
typedef __bf16 bf16x2 __attribute__((ext_vector_type(2)));
typedef float f32x2 __attribute__((ext_vector_type(2)));
constexpr float USCALE = 64.f;
constexpr size_t SHARD_BYTES = (size_t)16384 * 128;
struct Split { int xs0, xs1, nq, q; };
__device__ __forceinline__ Split split(int tid) { Split s; const int G = gridDim.x, b = blockIdx.x; if (G % 8 == 0) { s.xs0 = b & 7; s.xs1 = s.xs0 + 1; s.nq = (G >> 3) * NWAVE; s.q = (b >> 3) * NWAVE + __builtin_amdgcn_readfirstlane(tid >> 6); } else { s.xs0 = 0; s.xs1 = 8; s.nq = G * NWAVE; s.q = b * NWAVE + __builtin_amdgcn_readfirstlane(tid >> 6); } return s; }

__device__ __forceinline__ void u_phase(const Params& p) {
    const int tid = otid(), lane = tid & 63, g = lane >> 3, c = lane & 7;
    const unsigned char* h8 = p.ws + WS_H8; const bf16_t* ids = (const bf16_t*)(p.ws + WS_IDS); bf16_t* apart = (bf16_t*)(p.ws + WS_PQ);
    const Split sp = split(tid);
    const int j0 = ((lane >> 2) & 1) * 8 + ((lane >> 1) & 1) * 4 + (lane & 1) * 2;
    for (int xs = sp.xs0; xs < sp.xs1; ++xs) {
        const unsigned char* U8 = p.ws + WS_PU + (size_t)xs * SHARD_BYTES + c * 16;
        const unsigned char* hb = h8 + xs * 128 + c * 16;
        v4u uA[16], uB[16], hA[1], hB[1], iA[2], iB[2];
#define U_IDS(I, tk) do { const int tc_ = (tk) < T ? (tk) : T - 1; const v4u* ip_ = (const v4u*)(ids + (size_t)tc_ * 128 + g * 16); I[0] = ip_[0]; I[1] = ip_[1]; } while (0)
#define U_GATHER(U, H, I, tk) do { const int tc_ = (tk) < T ? (tk) : T - 1; H[0] = *(const v4u*)(hb + (size_t)tc_ * D); \
        _Pragma("unroll") for (int j = 0; j < 16; ++j) U[j] = *(const v4u*)(U8 + (size_t)((I[j >> 3][(j >> 1) & 3] >> (16 * (j & 1))) & 0xffffu) * 128); } while (0)
#define U_COMPUTE(U, H, tk) do { { float d[16]; \
        _Pragma("unroll") for (int j = 0; j < 16; ++j) { int s_ = 0; \
            _Pragma("unroll") for (int k = 0; k < 4; ++k) s_ = __builtin_amdgcn_sdot4((int)U[j][k], (int)H[0][k], s_, false); \
            d[j] = (float)s_; } \
        float q8[8], q4[4], q2[2]; \
        _Pragma("unroll") for (int i = 0; i < 8; ++i) { const float snd = (lane & 4) ? d[i] : d[i + 8]; q8[i] = ((lane & 4) ? d[i + 8] : d[i]) + shx<4>(snd); } \
        _Pragma("unroll") for (int i = 0; i < 4; ++i) { const float snd = (lane & 2) ? q8[i] : q8[i + 4]; q4[i] = ((lane & 2) ? q8[i + 4] : q8[i]) + shx<2>(snd); } \
        _Pragma("unroll") for (int i = 0; i < 2; ++i) { const float snd = (lane & 1) ? q4[i] : q4[i + 2]; q2[i] = ((lane & 1) ? q4[i + 2] : q4[i]) + shx<1>(snd); } \
        if ((tk) < T) *(unsigned*)(apart + ((size_t)(tk) * 8 + xs) * 128 + g * 16 + j0) = pk2(q2[0], q2[1]); } } while (0)
        const int nq = sp.nq;
        U_IDS(iA, sp.q); U_IDS(iB, sp.q + nq);
        U_GATHER(uA, hA, iA, sp.q);
        for (int t = sp.q; t < T; t += 2 * nq) {
            U_IDS(iA, t + 2 * nq); U_GATHER(uB, hB, iB, t + nq); U_COMPUTE(uA, hA, t);
            U_IDS(iB, t + 3 * nq); U_GATHER(uA, hA, iA, t + 2 * nq); U_COMPUTE(uB, hB, t + nq);
        }
#undef U_IDS
#undef U_GATHER
#undef U_COMPUTE
    }
}
__device__ __forceinline__ void combine_phase(const Params& p) {
    const bf16_t* apart = (const bf16_t*)(p.ws + WS_PQ); const float* gw = (const float*)(p.ws + WS_G);
    for (int i = blockIdx.x * NTHR + otid(); i < T * 16; i += gridDim.x * NTHR) {
        const int t = i >> 4, e0 = (i & 15) * 8; float a[8];
#pragma unroll
        for (int k = 0; k < 8; ++k) a[k] = 0.f;
        v4u pv[8];
#pragma unroll
        for (int x = 0; x < 8; ++x) pv[x] = *(const v4u*)(apart + ((size_t)t * 8 + x) * 128 + e0);
        const f32x4 g0 = *(const f32x4*)(gw + (size_t)t * 128 + e0), g1 = *(const f32x4*)(gw + (size_t)t * 128 + e0 + 4);
#pragma unroll
        for (int x = 0; x < 8; ++x)
#pragma unroll
            for (int k = 0; k < 4; ++k) { a[2 * k] += __uint_as_float(pv[x][k] << 16); a[2 * k + 1] += __uint_as_float(pv[x][k] & 0xffff0000u); }
        { const v4u idw = *(const v4u*)((const bf16_t*)(p.ws + WS_IDS) + (size_t)t * 128 + e0); const float sht = ((const float*)(p.ws + WS_SH))[t]; const float* su = (const float*)(p.ws + WS_SU);
#pragma unroll
          for (int k = 0; k < 8; ++k) a[k] *= su[(idw[k >> 1] >> (16 * (k & 1))) & 0xffffu] * sht; }
        float w[8];
#pragma unroll
        for (int k = 0; k < 8; ++k) { const float u3 = 0.7978845608028654f * (a[k] + 0.044715f * a[k] * a[k] * a[k]); w[k] = (k < 4 ? g0[k] : g1[k - 4]) * 0.5f * a[k] * (1.f + tanhf(u3)) * (1.f / USCALE); }
        { int h0 = __builtin_amdgcn_cvt_pk_fp8_f32(w[0] * 4096.f, w[1] * 4096.f, 0, false); h0 = __builtin_amdgcn_cvt_pk_fp8_f32(w[2] * 4096.f, w[3] * 4096.f, h0, true);
          int h1 = __builtin_amdgcn_cvt_pk_fp8_f32(w[4] * 4096.f, w[5] * 4096.f, 0, false); h1 = __builtin_amdgcn_cvt_pk_fp8_f32(w[6] * 4096.f, w[7] * 4096.f, h1, true);
          const f32x2 a0 = __builtin_amdgcn_cvt_pk_f32_fp8(h0, false), a1 = __builtin_amdgcn_cvt_pk_f32_fp8(h0, true), a2 = __builtin_amdgcn_cvt_pk_f32_fp8(h1, false), a3 = __builtin_amdgcn_cvt_pk_f32_fp8(h1, true);
          int l0 = __builtin_amdgcn_cvt_pk_fp8_f32(w[0] * 4096.f - a0.x, w[1] * 4096.f - a0.y, 0, false); l0 = __builtin_amdgcn_cvt_pk_fp8_f32(w[2] * 4096.f - a1.x, w[3] * 4096.f - a1.y, l0, true);
          int l1 = __builtin_amdgcn_cvt_pk_fp8_f32(w[4] * 4096.f - a2.x, w[5] * 4096.f - a2.y, 0, false); l1 = __builtin_amdgcn_cvt_pk_fp8_f32(w[6] * 4096.f - a3.x, w[7] * 4096.f - a3.y, l1, true);
          unsigned char* wr_ = p.ws + WS_WB + (size_t)t * 256 + 8 * (e0 & 15) + (e0 >> 4);
#pragma unroll
          for (int k = 0; k < 8; ++k) { wr_[8 * k] = (unsigned char)(((k < 4 ? h0 : h1) >> (8 * (k & 3))) & 255); wr_[128 + 8 * k] = (unsigned char)(((k < 4 ? l0 : l1) >> (8 * (k & 3))) & 255); } }
    }
}
__device__ __forceinline__ void v_phase(const Params& p, LAS unsigned char* lds) {
    typedef int v2i_t __attribute__((ext_vector_type(2)));
    typedef unsigned v2u_t __attribute__((ext_vector_type(2)));
    const int tid = otid(), lane = tid & 63, r = lane >> 3, pc = lane & 7, li = lane & 15, kg = lane >> 4;
    const int wv = __builtin_amdgcn_readfirstlane(tid >> 6);
    const unsigned char* ids8 = p.ws + WS_IDS; const unsigned char* w8 = p.ws + WS_WB; bf16_t* y2 = (bf16_t*)(p.ws + WS_H);
    LAS unsigned char* img = lds + wv * 16384;
    LAS unsigned char* aux = lds + 131072 + wv * 1024;
    const int swz = (4 * kg + (li >> 2)) & 7;
    const int rd0 = (8 * kg + (li >> 1)) * 128 + 8 * (li & 1);
    const Split sp = split(tid);
    for (int xs = sp.xs0; xs < sp.xs1; ++xs) {
        const unsigned char* V8 = p.ws + WS_PV + (size_t)xs * SHARD_BYTES;
        v4u I[2]; v2u_t W[4];
        unsigned ra[8];
#pragma unroll
        for (int db = 0; db < 8; ++db) ra[db] = (unsigned)(size_t)img + rd0 + ((db ^ swz) << 4);
#define V_TC(tk) ((tk) < T ? (tk) : T - 1)
#define V_DMA_IDS(tk, buf) __builtin_amdgcn_global_load_lds((const unsigned*)(ids8 + (size_t)V_TC(tk) * 256 + lane * 4), (LAS unsigned*)(aux + (buf) * 256), 4, 0, 0)
#define V_DMA_W(tk, buf) __builtin_amdgcn_global_load_lds((const unsigned*)(w8 + (size_t)V_TC(tk) * 256 + lane * 4), (LAS unsigned*)(aux + 512 + (buf) * 256), 4, 0, 0)
#define V_RD_IDS(buf) do { I[0] = *(const LAS v4u*)(aux + (buf) * 256 + r * 32); I[1] = *(const LAS v4u*)(aux + (buf) * 256 + r * 32 + 16); } while (0)
#define V_RD_W(buf) do { _Pragma("unroll") for (int eb = 0; eb < 4; ++eb) { W[eb] = *(const LAS v2u_t*)(aux + 512 + (buf) * 256 + 128 * (li & 1) + 32 * eb + 8 * kg); } } while (0)
#define V_DMA(eb) do { _Pragma("unroll") for (int q = 0; q < 4; ++q) { const int j_ = 4 * (eb) + q; const unsigned id_ = (I[j_ >> 3][(j_ >> 1) & 3] >> (16 * (j_ & 1))) & 0xffffu; \
            __builtin_amdgcn_global_load_lds((const unsigned*)(V8 + (size_t)id_ * 128 + ((pc ^ ((4 * q + (lane >> 4)) & 7)) << 4)), (LAS unsigned*)(img + (eb) * 4096 + q * 1024), 16, 0, 0); } } while (0)
#define V_L64(q) ((long)(((unsigned long long)(q).y << 32) | (unsigned long long)(q).x))
#define V_VM(n) asm volatile("s_waitcnt vmcnt(" #n ")" ::: "memory")
#define V_STEP(tk, par) do { \
        V_VM(16); \
        V_RD_IDS((par) ^ 1); V_RD_W(par);                                            \
        asm volatile("s_waitcnt lgkmcnt(0)" ::: "memory"); \
        V_DMA_IDS((tk) + 2 * nq, par); V_DMA_W((tk) + nq, (par) ^ 1); \
        f32x4 acc[8]; \
        _Pragma("unroll") for (int db = 0; db < 8; ++db) acc[db] = (f32x4){0.f, 0.f, 0.f, 0.f}; \
        _Pragma("unroll") for (int eb = 0; eb < 4; ++eb) { long b_[8]; \
            V_VM(14); \
            _Pragma("unroll") for (int db = 0; db < 8; ++db) asm volatile("ds_read_b64_tr_b8 %0, %1 offset:%2" : "=v"(b_[db]) : "v"(ra[db]), "n"(eb * 4096) : "memory"); \
            asm volatile("s_waitcnt lgkmcnt(0)" : "+v"(b_[0]), "+v"(b_[1]), "+v"(b_[2]), "+v"(b_[3]), "+v"(b_[4]), "+v"(b_[5]), "+v"(b_[6]), "+v"(b_[7]) :: "memory"); \
            _Pragma("unroll") for (int db = 0; db < 8; ++db) acc[db] = __builtin_amdgcn_mfma_f32_16x16x32_fp8_fp8(V_L64(W[eb]), b_[db], acc[db], 0, 0, 0); \
            asm volatile("s_waitcnt lgkmcnt(0)" ::: "memory");                       \
            V_DMA(eb); } \
        float o0_ = acc[0][0] + acc[0][1], o1_ = acc[4][0] + acc[4][1];              \
        _Pragma("unroll") for (int q_ = 1; q_ < 4; ++q_) { o0_ = (kg == q_) ? acc[q_][0] + acc[q_][1] : o0_; o1_ = (kg == q_) ? acc[4 + q_][0] + acc[4 + q_][1] : o1_; } \
        { bf16_t* yp_ = y2 + (size_t)V_TC(tk) * D + xs * 128 + li; yp_[16 * kg] = f2bf(o0_ * (1.f / 4096.f)); yp_[16 * (4 + kg)] = f2bf(o1_ * (1.f / 4096.f)); } } while (0)
        const int nq = sp.nq;
        V_DMA_IDS(sp.q, 0); V_DMA_W(sp.q, 0);
        V_VM(0);
        V_RD_IDS(0);
        asm volatile("s_waitcnt lgkmcnt(0)" ::: "memory");
        V_DMA_IDS(sp.q + nq, 1);
        V_DMA(0); V_DMA(1); V_DMA(2); V_DMA(3);
        { unsigned* dmy = (unsigned*)(p.ws + 500 * MiB) + (size_t)(blockIdx.x * NWAVE + wv) * 128 + lane; dmy[0] = 0u; dmy[64] = 0u; }
        for (int t = sp.q; t < T; t += 2 * nq) { V_STEP(t, 0); V_STEP(t + nq, 1); }
        V_VM(0);
#undef V_TC
#undef V_DMA_IDS
#undef V_DMA_W
#undef V_RD_IDS
#undef V_RD_W
#undef V_DMA
#undef V_L64
#undef V_VM
#undef V_STEP
    }
}
__device__ __forceinline__ void final_phase(const Params& p) {
    const int tid = otid(), lane = tid & 63, wave = tid >> 6;
    const float* mod = (const float*)(p.ws + WS_MOD); const bf16_t* x1 = (const bf16_t*)(p.ws + WS_X1); const bf16_t* y2 = (const bf16_t*)(p.ws + WS_H);
    constexpr int RW = 4;
    const int rpb = (T + gridDim.x - 1) / gridDim.x, r0 = blockIdx.x * rpb, r1 = (r0 + rpb < T) ? r0 + rpb : T;
    int cb = -1; f32x4 gc[4];
    for (int t0 = r0 + wave; t0 < r1; t0 += NWAVE * RW) {
        uint2 xa[RW][4], za[RW][4];
#pragma unroll
        for (int i = 0; i < RW; ++i) { const int t = t0 + i * NWAVE < r1 ? t0 + i * NWAVE : t0;
#pragma unroll
            for (int j = 0; j < 4; ++j) { xa[i][j] = *(const uint2*)(x1 + (size_t)t * D + lane * 4 + 256 * j); za[i][j] = *(const uint2*)(y2 + (size_t)t * D + lane * 4 + 256 * j); } }
#pragma unroll
        for (int i = 0; i < RW; ++i) { const int t = t0 + i * NWAVE; if (t < r1) {
            const int bb = __builtin_amdgcn_readfirstlane(t / S);
            if (bb != cb) { cb = bb; const float* mb = mod + bb * 6144;
#pragma unroll
                for (int j = 0; j < 4; ++j) { const int col = lane * 4 + 256 * j; gc[j] = *(const f32x4*)(p.g_post_ffn + col) * *(const f32x4*)(mb + 5120 + col); } }
            f32x4 xv[4], zv[4]; float s2 = 0.f;
#pragma unroll
            for (int j = 0; j < 4; ++j) { const uint2 xw = xa[i][j], zw = za[i][j];
                xv[j] = (f32x4){__uint_as_float(xw.x << 16), __uint_as_float(xw.x & 0xffff0000u), __uint_as_float(xw.y << 16), __uint_as_float(xw.y & 0xffff0000u)};
                zv[j] = (f32x4){__uint_as_float(zw.x << 16), __uint_as_float(zw.x & 0xffff0000u), __uint_as_float(zw.y << 16), __uint_as_float(zw.y & 0xffff0000u)};
                s2 += zv[j][0] * zv[j][0] + zv[j][1] * zv[j][1] + zv[j][2] * zv[j][2] + zv[j][3] * zv[j][3]; }
            s2 = wave_sum(s2); const float r2 = rsqrtf(s2 * (1.f / D) + EPS);
#pragma unroll
            for (int j = 0; j < 4; ++j) { const int col = lane * 4 + 256 * j; *(f32x4*)(p.out + (size_t)t * D + col) = xv[j] + zv[j] * r2 * gc[j]; }
        } }
    }
}
}

#define GAS __attribute__((address_space(1)))
typedef GAS unsigned gu32;
#define RLX_AGENT __ATOMIC_RELAXED, __HIP_MEMORY_SCOPE_AGENT
#define XB_TMO      128
#define XB_XCNT(j)  (256  + 64 * (j))
#define XB_XSUB(j)  (1280 + 64 * (j))
#define XB_XGEN(j)  (2304 + 64 * (j))
#define XB_TOP      3328
#define XB_TOPGEN   3392
#define XCD_BAR_WORDS 3456
#define XB_SPIN_CAP (1u << 18)

__device__ __forceinline__ unsigned xb_ld(unsigned* p)              { return __hip_atomic_load(p, __ATOMIC_RELAXED, __HIP_MEMORY_SCOPE_AGENT); }
__device__ __forceinline__ unsigned xb_add(unsigned* p, unsigned v) { return __hip_atomic_fetch_add(p, v, __ATOMIC_RELAXED, __HIP_MEMORY_SCOPE_AGENT); }
__device__ __forceinline__ unsigned xb_xcc_id() { return (unsigned)__builtin_amdgcn_s_getreg((3 << 11) | 20) & 0xFu; }
#define XB_SPIN(cond, bar) do { unsigned _sp = 0; while (cond) { __builtin_amdgcn_s_sleep(1); \
    if ((++_sp & 255u) == 0u) { if (xb_ld(&(bar)[XB_TMO])) break; if (_sp > XB_SPIN_CAP) { atomicAdd(&(bar)[XB_TMO], 1u); break; } } } } while (0)

struct XcdBarrier {
    unsigned* bar; unsigned x;
    volatile LAS unsigned* st;
};

__device__ __forceinline__ XcdBarrier xcd_barrier_post(unsigned* bar, volatile LAS unsigned* st) {
    XcdBarrier b; b.bar = bar; b.x = xb_xcc_id(); b.st = st;
    if (threadIdx.x == 0) (void)xb_add(&bar[XB_XCNT(b.x)], 1u);
    return b;
}
__device__ __forceinline__ void xcd_barrier_complete(unsigned* bar, unsigned x, unsigned& nloc, unsigned& nx) {
    const unsigned G = gridDim.x * gridDim.y * gridDim.z;
    unsigned sum, cnt, mine, sp = 0u;
    for (;;) {
        sum = 0u; cnt = 0u; mine = 0u;
#pragma unroll
        for (unsigned j = 0; j < 16; ++j) { const unsigned c = xb_ld(&bar[XB_XCNT(j)]); sum += c; cnt += (c > 0u) ? 1u : 0u; mine = (j == x) ? c : mine; }
        if (sum == G) break;
        __builtin_amdgcn_s_sleep(1);
        if ((++sp & 255u) == 0u) { if (xb_ld(&bar[XB_TMO])) break; if (sp > XB_SPIN_CAP) { atomicAdd(&bar[XB_TMO], 1u); break; } }
    }
    nloc = mine > 0u ? mine : 1u; nx = cnt > 0u ? cnt : 1u;
}

__device__ __forceinline__ void xcd_barrier(const XcdBarrier& b) {
    asm volatile("s_waitcnt vmcnt(0)" ::: "memory");
    __syncthreads();
    if (threadIdx.x == 0) {
        unsigned* bar = b.bar;
        __builtin_amdgcn_s_waitcnt(0);
        unsigned nloc = b.st[0], nx = b.st[1];
        if (nloc == 0u) { xcd_barrier_complete(bar, b.x, nloc, nx); b.st[0] = nloc; b.st[1] = nx; }
        const unsigned old = xb_add(&bar[XB_XSUB(b.x)], 1u);
        const unsigned gen = old / nloc;
        if (old + 1u == (gen + 1u) * nloc) {
            __builtin_amdgcn_fence(__ATOMIC_RELEASE, "agent");
            asm volatile("s_waitcnt vmcnt(0)" ::: "memory");
            const unsigned og = xb_add(&bar[XB_TOP], 1u);
            const unsigned tg = og / nx;
            if (og + 1u == (tg + 1u) * nx) xb_add(&bar[XB_TOPGEN], 1u);
            else XB_SPIN(xb_ld(&bar[XB_TOPGEN]) == tg, bar);
            __builtin_amdgcn_fence(__ATOMIC_ACQUIRE, "agent");
            xb_add(&bar[XB_XGEN(b.x)], 1u);
            asm volatile("s_waitcnt vmcnt(0)" ::: "memory");
        } else {
            XB_SPIN(xb_ld(&bar[XB_XGEN(b.x)]) == gen, bar);
            __builtin_amdgcn_fence(__ATOMIC_ACQUIRE, "agent");
            asm volatile("s_waitcnt vmcnt(0)" ::: "memory");
        }
    }
    __syncthreads();
}


constexpr int MISC_OFF = LDS_BYTES - 256;
constexpr int CW_BAR = 1024;
constexpr size_t CTL_ZERO_BYTES = 32768;
static_assert((CW_BAR + XCD_BAR_WORDS) * 4 <= (int)CTL_ZERO_BYTES, "control region");
static_assert(att::L_END <= MISC_OFF && pg8::STAGE_BYTES <= MISC_OFF, "LDS map");

__device__ __forceinline__ void gemm_dispatch(const Params& p, LAS unsigned char* lds, int which) {
    unsigned char* ws = p.ws;
    if (which == 0) {
        pg8::Gemm g{(const bf16_t*)(ws + WS_H), (const bf16_t*)(ws + WS_WINT), T, NP, D / 2}; pg8::StaticOrder S_; S_.init(T, NP, gridDim.x, blockIdx.x);
        pg8::EpiI8S E{(bf16_t*)(ws + WS_PROJ), NP, (const float*)(ws + WS_S1), (const float*)(ws + WS_CS)};
        pg8::gemm_phase<pg8::EpiI8S, pg8::StaticOrder, true, true, true>(lds, g, S_, E);
    } else if (which == 1) {
        pg8::Gemm g{(const bf16_t*)(ws + WS_OCAT), (const bf16_t*)(ws + WS_WOT), T, D, D}; pg8::StaticOrder S_; S_.init(T, D, gridDim.x, blockIdx.x);
        pg8::EpiBf16S E{(bf16_t*)(ws + WS_PROJ), D, 0u, 1.f};
        pg8::gemm_phase<pg8::EpiBf16S, pg8::StaticOrder, true, true>(lds, g, S_, E);
    } else {
        pg8::Gemm g{(const bf16_t*)(ws + WS_H8), (const bf16_t*)(ws + WS_WPQT), T, 2048, D / 2}; pg8::StaticOrder S_; S_.init(T, 2048, gridDim.x, blockIdx.x);
        pg8::EpiI8S E{(bf16_t*)(ws + WS_PQ), 2048, (const float*)(ws + WS_SH), (const float*)(ws + WS_CS) + 3072};
        pg8::gemm_phase<pg8::EpiI8S, pg8::StaticOrder, true, true, true>(lds, g, S_, E);
    }
}

__global__ __launch_bounds__(NTHR, 2) void k_mega(Params p) {
    extern __shared__ __attribute__((aligned(16))) unsigned char lds_raw[];
    LAS unsigned char* lds = (LAS unsigned char*)lds_raw;
    volatile LAS unsigned* MISC = (volatile LAS unsigned*)(lds + MISC_OFF);
    if (threadIdx.x < 64) MISC[threadIdx.x] = 0u;
    __syncthreads();
    XcdBarrier bar = xcd_barrier_post((unsigned*)(p.ws + WS_CTL) + CW_BAR, MISC + 8);
    phase0(p, lds);                  xcd_barrier(bar);
    rw::norm1_phase(p, lds);         xcd_barrier(bar);
    gemm_dispatch(p, lds, 0);        xcd_barrier(bar);
    att::attn_phase(p, lds);         xcd_barrier(bar);
    gemm_dispatch(p, lds, 1);        xcd_barrier(bar);
    rw::post1_phase(p);              xcd_barrier(bar);
    gemm_dispatch(p, lds, 2);        xcd_barrier(bar);
    tk::topk_phase(p, lds);          xcd_barrier(bar);
    sh::u_phase(p);                  xcd_barrier(bar);
    sh::combine_phase(p);            xcd_barrier(bar);
    sh::v_phase(p, lds);             xcd_barrier(bar);
    sh::final_phase(p);
}

extern "C" void kernel_launch(void* const* d_in, const int* in_sizes, int n_in, void* d_out, int out_size, void* d_ws, size_t ws_size, hipStream_t stream) {
    Params p{};
    const float** pp = (const float**)&p;
    for (int i = 0; i < 21; ++i) pp[i] = (const float*)d_in[i];
    p.out = (float*)d_out; p.ws = (unsigned char*)d_ws;
    static int grid = 0;
    if (!grid) {
        (void)hipFuncSetAttribute((const void*)k_mega, hipFuncAttributeMaxDynamicSharedMemorySize, LDS_BYTES);
        int dev = 0, cus = 0, per_cu = 0; (void)hipGetDevice(&dev); (void)hipDeviceGetAttribute(&cus, hipDeviceAttributeMultiprocessorCount, dev);
        (void)hipOccupancyMaxActiveBlocksPerMultiprocessor(&per_cu, (const void*)k_mega, NTHR, LDS_BYTES);
        if (cus <= 0) cus = 256; if (per_cu < 1) per_cu = 1;
        grid = cus * 1;
    }
    (void)hipMemsetAsync((char*)d_ws + WS_CTL, 0, CTL_ZERO_BYTES, stream);
    void* args[] = {(void*)&p};
    (void)hipLaunchCooperativeKernel((const void*)k_mega, dim3(grid), dim3(NTHR), args, LDS_BYTES, stream);
}
```
